# Optimizing an MI355X kernel written in HIP

```python
import math
import jax, jax.numpy as jnp
from jax import lax
import numpy as np

D_MODEL = 1024
BATCH = 32
SEQ = 2048
DEPTH = 1
DEC_BATCH = 16
DEC_SEQ = 2048
PAST_LEN = 128

HEAD_DIM = 64
HEADS_PER_GROUP = 4
ATTN_PATTERNS = ((128, 1), (512, 4), (2048, 16))
N_ATTN_HEADS = HEADS_PER_GROUP * len(ATTN_PATTERNS)
ATTN_WIDTH = N_ATTN_HEADS * HEAD_DIM
ATTN_OUT_WIDTH = HEADS_PER_GROUP * HEAD_DIM
ROPE_DIM = HEAD_DIM // 4
ROPE_THETA = 500000.0
POOL_WINDOWS = (2, 4, 8, 16)
POOL_WIDTH = D_MODEL // 2
POOL_GROUP = POOL_WIDTH // len(POOL_WINDOWS)
IN_WIDTH = POOL_WIDTH + 3 * ATTN_WIDTH
D_FF = -(-8 * D_MODEL // (3 * 256)) * 256
BLOCK_Q = 64
NORM_EPS = 1e-6

kernel_name = "gated_pool_dilated_attn_encoder"


def rmsnorm(x, g):
    xf = x.astype(jnp.float32)
    y = xf * lax.rsqrt(jnp.mean(xf * xf, axis=-1, keepdims=True) + NORM_EPS) * g.astype(jnp.float32)
    return y.astype(x.dtype)


def partial_rope(t, pos):
    half = ROPE_DIM // 2
    inv = jnp.asarray(ROPE_THETA ** (-np.arange(half, dtype=np.float32) / half), dtype=jnp.float32)
    ang = pos[:, None] * inv[None, :]
    cos = jnp.cos(ang)[None, :, None, :]
    sin = jnp.sin(ang)[None, :, None, :]
    tf = t.astype(jnp.float32)
    x1 = tf[..., :half]
    x2 = tf[..., half:ROPE_DIM]
    rot = jnp.concatenate([x1 * cos - x2 * sin, x2 * cos + x1 * sin, tf[..., ROPE_DIM:]], axis=-1)
    return rot.astype(t.dtype)


def pool_mixer(u, maps, scale):
    B, S, _ = u.shape
    uf = u.astype(jnp.float32)
    c = jnp.pad(jnp.cumsum(uf, axis=1), ((0, 0), (1, 0), (0, 0)))
    pos = np.arange(S)
    outs = []
    for g, w in enumerate(POOL_WINDOWS):
        sl = slice(g * POOL_GROUP, (g + 1) * POOL_GROUP)
        lo = np.clip(pos - w // 2, 0, S)
        hi = np.clip(pos + w // 2, 0, S)
        cnt = jnp.asarray((hi - lo).astype(np.float32))[None, :, None]
        cg = c[..., sl]
        outs.append((cg[:, hi] - cg[:, lo]) / cnt - uf[..., sl])
    pooled = jnp.stack(outs, axis=2)
    mixed = jnp.einsum('bsgc,gcd->bsgd', pooled, maps.astype(jnp.float32)).reshape(B, S, POOL_WIDTH)
    return (mixed * scale.astype(jnp.float32)).astype(u.dtype)


def dilated_window_attention(q, k, v, window, dilation):
    B, S, H, E = q.shape
    d = dilation
    n = S // d
    R = (window // 2) // d
    qb = math.gcd(n, BLOCK_Q)
    nb = n // qb
    span = qb + 2 * R

    def to_sub(t):
        return t.reshape(B, n, d, H, E).transpose(0, 2, 1, 3, 4)

    qs = to_sub(q).reshape(B, d, nb, qb, H, E)
    pad = ((0, 0), (0, 0), (R, R), (0, 0), (0, 0))
    kp = jnp.pad(to_sub(k), pad)
    vp = jnp.pad(to_sub(v), pad)
    kidx = np.arange(nb)[:, None] * qb + np.arange(span)[None, :]
    kb = kp[:, :, kidx]
    vb = vp[:, :, kidx]
    s = jnp.einsum('bdnqhe,bdnkhe->bdnhqk', qs, kb, preferred_element_type=jnp.float32) * (E ** -0.5)
    rel = np.arange(span)[None, :] - R - np.arange(qb)[:, None]
    key_sub = kidx - R
    mask = (np.abs(rel) <= R)[None] & ((key_sub >= 0) & (key_sub < n))[:, None, :]
    s = jnp.where(jnp.asarray(mask)[None, None, :, None], s, -jnp.inf)
    m = jnp.max(s, axis=-1, keepdims=True)
    p = jnp.exp(s - m)
    den = jnp.sum(p, axis=-1, keepdims=True)
    o = jnp.einsum('bdnhqk,bdnkhe->bdnqhe', p, vb.astype(jnp.float32)) / den.transpose(0, 1, 2, 4, 3, 5)
    lse = (m + jnp.log(den))[..., 0].transpose(0, 1, 2, 4, 3)
    o = o.reshape(B, d, n, H, E).transpose(0, 2, 1, 3, 4).reshape(B, S, H, E)
    lse = lse.reshape(B, d, n, H).transpose(0, 2, 1, 3).reshape(B, S, H)
    return o, lse


def attention_branch(z_attn):
    B, S, _ = z_attn.shape
    q = z_attn[..., :ATTN_WIDTH].reshape(B, S, N_ATTN_HEADS, HEAD_DIM)
    k = z_attn[..., ATTN_WIDTH:2 * ATTN_WIDTH].reshape(B, S, N_ATTN_HEADS, HEAD_DIM)
    v = z_attn[..., 2 * ATTN_WIDTH:].reshape(B, S, N_ATTN_HEADS, HEAD_DIM)
    pos = jnp.arange(S, dtype=jnp.float32)
    q = partial_rope(q, pos)
    k = partial_rope(k, pos)
    outs, lses = [], []
    for g, (w, dil) in enumerate(ATTN_PATTERNS):
        hs = slice(g * HEADS_PER_GROUP, (g + 1) * HEADS_PER_GROUP)
        o, l = dilated_window_attention(q[:, :, hs], k[:, :, hs], v[:, :, hs], w, dil)
        outs.append(o)
        lses.append(l)
    outs = jnp.stack(outs, axis=0)
    alpha = jax.nn.softmax(jnp.stack(lses, axis=0), axis=0)
    merged = jnp.sum(alpha[..., None] * outs, axis=0).reshape(B, S, ATTN_OUT_WIDTH)
    return merged.astype(z_attn.dtype)


def encoder_forward(x, norm_mix, w_in, pool_maps, pool_scale, w_up_pool, w_up_attn, w_gate, b_gate,
                    w_out, norm_ffn, w_ffn_gate, w_ffn_up, w_ffn_down, norm_final):
    for l in range(DEPTH):
        h = rmsnorm(x, norm_mix[l])
        z = h @ w_in[l]
        a = pool_mixer(z[..., :POOL_WIDTH], pool_maps[l], pool_scale[l]) @ w_up_pool[l]
        b = attention_branch(z[..., POOL_WIDTH:]) @ w_up_attn[l]
        gates = jax.nn.sigmoid(h @ w_gate[l] + b_gate[l])
        g_a = gates[..., :D_MODEL]
        g_b = gates[..., D_MODEL:]
        x = x + (g_a * a + g_b * b) @ w_out[l]
        h = rmsnorm(x, norm_ffn[l])
        x = x + (jax.nn.silu(h @ w_ffn_gate[l]) * (h @ w_ffn_up[l])) @ w_ffn_down[l]
    return rmsnorm(x, norm_final)


def setup_inputs(seed: int = 0) -> dict:
    key = jax.random.key(seed)
    ks = jax.random.split(key, 18)
    f32 = jnp.float32

    def dense(k, shape, fan_in):
        return jax.random.normal(k, shape, f32) * (fan_in ** -0.5)

    def gain(k, shape):
        return 1.0 + 0.05 * jax.random.normal(k, shape, f32)

    return {
        "x_prompt": jax.random.normal(ks[0], (BATCH, SEQ, D_MODEL), f32),
        "x_sample": jax.random.normal(ks[1], (DEC_BATCH, DEC_SEQ, D_MODEL), f32),
        "norm_mix": gain(ks[2], (DEPTH, D_MODEL)),
        "w_in": dense(ks[3], (DEPTH, D_MODEL, IN_WIDTH), D_MODEL),
        "pool_maps": dense(ks[4], (DEPTH, len(POOL_WINDOWS), POOL_GROUP, POOL_GROUP), POOL_GROUP),
        "pool_scale": gain(ks[5], (DEPTH, POOL_WIDTH)),
        "w_up_pool": dense(ks[6], (DEPTH, POOL_WIDTH, D_MODEL), POOL_WIDTH),
        "w_up_attn": dense(ks[7], (DEPTH, ATTN_OUT_WIDTH, D_MODEL), ATTN_OUT_WIDTH),
        "w_gate": dense(ks[8], (DEPTH, D_MODEL, 2 * D_MODEL), D_MODEL),
        "b_gate": 0.02 * jax.random.normal(ks[9], (DEPTH, 2 * D_MODEL), f32),
        "w_out": dense(ks[10], (DEPTH, D_MODEL, D_MODEL), D_MODEL),
        "norm_ffn": gain(ks[11], (DEPTH, D_MODEL)),
        "w_ffn_gate": dense(ks[12], (DEPTH, D_MODEL, D_FF), D_MODEL),
        "w_ffn_up": dense(ks[13], (DEPTH, D_MODEL, D_FF), D_MODEL),
        "w_ffn_down": dense(ks[14], (DEPTH, D_FF, D_MODEL), D_FF),
        "norm_final": gain(ks[15], (D_MODEL,)),
    }


def reference(x_prompt, x_sample, norm_mix, w_in, pool_maps, pool_scale, w_up_pool, w_up_attn, w_gate, b_gate,
              w_out, norm_ffn, w_ffn_gate, w_ffn_up, w_ffn_down, norm_final):
    y_prompt = encoder_forward(x_prompt, norm_mix, w_in, pool_maps, pool_scale, w_up_pool, w_up_attn, w_gate,
                               b_gate, w_out, norm_ffn, w_ffn_gate, w_ffn_up, w_ffn_down, norm_final)
    y_sample = encoder_forward(x_sample, norm_mix, w_in, pool_maps, pool_scale, w_up_pool, w_up_attn, w_gate,
                               b_gate, w_out, norm_ffn, w_ffn_gate, w_ffn_up, w_ffn_down, norm_final)
    return (y_prompt, y_sample)
```

```cpp
#include <hip/hip_runtime.h>
#include <cstdio>
#include <cstdint>
namespace pg8 {
#define PG8_LAS __attribute__((address_space(3)))
typedef unsigned short bf16_t;
typedef short bf16x8 __attribute__((ext_vector_type(8)));
typedef float f32x4 __attribute__((ext_vector_type(4)));
typedef unsigned u32x4 __attribute__((ext_vector_type(4)));
constexpr int BM = 256, BK = 64, HALF = 128, HTB = HALF * BK * 2  , STAGE_BYTES = 8 * HTB, NXCD = 8, WGM = 8;

__host__ __device__ __forceinline__ int lds_byte(int r, int c) { const int st = (r >> 4) * 2 + (c >> 5), rr = r & 15, cc = c & 31, ob = rr * 64 + cc * 2; return st * 1024 + (ob ^ (((ob >> 9) & 1) << 5)); }
__host__ __device__ __forceinline__ void stage_rc(int b, int& R, int& C) { const int st = b / 1024, sb = b % 1024, swz = sb ^ (((sb >> 9) & 1) << 5); R = (st >> 1) * 16 + swz / 64; C = (st & 1) * 32 + (swz % 64) / 2; }
__host__ __device__ __forceinline__ int perm32(int rho) { const int n = rho >> 4, i = rho & 15; return 8 * (i >> 2) + 4 * n + (i & 3); }

struct Unit { int pm, pn; };
struct Gemm { const bf16_t* A; const bf16_t* Bt; int M, N, K; };

struct StaticOrder {
    int nM, nN, nwg, G, c;
    __host__ __device__ void init(int M, int N, int G_, int c_) { nM = M / BM; nN = N / BM; nwg = nM * nN; G = G_; c = c_; }
    __host__ __device__ bool next(int i, Unit& u) const {
        const long L = (long)i * G + c; if (L >= nwg) return false;
        int wgid = (int)L; { const int q = nwg / NXCD, r = nwg % NXCD, xcd = wgid % NXCD, off = wgid / NXCD; wgid = (xcd < r ? xcd * (q + 1) : r * (q + 1) + (xcd - r) * q) + off; }
        const int nig = WGM * nN, gid = wgid / nig, fm = gid * WGM, gsz = (nM - fm) < WGM ? (nM - fm) : WGM;
        u.pm = fm + ((wgid % nig) % gsz); u.pn = (wgid % nig) / gsz; return true;
    }
    __device__ __forceinline__ void a_ready(const Unit&) const {}
    __device__ __forceinline__ void done(const Unit&) const {}
};

__device__ __forceinline__ unsigned cvt_pk_bf16(float lo, float hi) { unsigned r; asm volatile("v_cvt_pk_bf16_f32 %0, %1, %2" : "=v"(r) : "v"(lo), "v"(hi)); return r; }
typedef float f32x2 __attribute__((ext_vector_type(2)));
__device__ __forceinline__ f32x2 gelu_pk(f32x2 v) {
    const f32x2 av = __builtin_elementwise_abs(v), d = av * 0.2316418882f + 1.0f;
    f32x2 t; t.x = __builtin_amdgcn_rcpf(d.x); t.y = __builtin_amdgcn_rcpf(d.y);
    f32x2 q = t * 0.5307027145f + (-0.7265760135f); q = q * t + 0.7107068705f; q = q * t + (-0.142248368f); q = q * t + 0.127414796f; q = q * t;
    const f32x2 s = (v * v) * (-0.72134752044f);
    f32x2 e; e.x = __builtin_amdgcn_exp2f(s.x); e.y = __builtin_amdgcn_exp2f(s.y);
    const f32x2 m = v * (q * e), r = v - m;
    f32x2 o; o.x = v.x < 0.f ? m.x : r.x; o.y = v.y < 0.f ? m.y : r.y; return o;
}

template <int ACT  > struct EpiBf16 {
    static constexpr bool PERM = true, AFTER_DRAIN = false; static_assert(ACT == 0 || ACT == 1, "EpiBf16: ACT is 0 (none) or 1 (gelu_pk)");
    bf16_t* O; int ldc; const float* bias; int split_cols; size_t split_stride; float scale0;
    __device__ __forceinline__ void operator()(const f32x4 (&acc)[2][2][4][2], const Unit& u, int wr, int wc, int fr, int fq) const {
        const int row0 = u.pm * BM + wr * 64 + fr; int colt = u.pn * BM; bf16_t* base = O;
        float sc = 1.f; if (split_cols) { const int t = colt / split_cols; base += (size_t)t * split_stride; colt -= t * split_cols; if (t == 0) sc = scale0; }
        const int col0 = colt + wc * 32 + 8 * fq, bcol0 = u.pn * BM + wc * 32 + 8 * fq;
        f32x4 bv[2][2];
#pragma unroll
        for (int bj = 0; bj < 2; ++bj)
#pragma unroll
            for (int n = 0; n < 2; ++n) bv[bj][n] = bias ? *(const f32x4*)(bias + bcol0 + bj * HALF + 4 * n) : (f32x4){0.f, 0.f, 0.f, 0.f};
#pragma unroll
        for (int ai = 0; ai < 2; ++ai)
#pragma unroll
            for (int m = 0; m < 4; ++m) { bf16_t* rowp = base + (size_t)(row0 + ai * HALF + m * 16) * ldc + col0;
#pragma unroll
                for (int bj = 0; bj < 2; ++bj) { f32x4 v0 = acc[ai][bj][m][0] + bv[bj][0], v1 = acc[ai][bj][m][1] + bv[bj][1];
                    if (ACT == 1) { f32x2 a = gelu_pk((f32x2){v0[0], v0[1]}), b = gelu_pk((f32x2){v0[2], v0[3]}), c = gelu_pk((f32x2){v1[0], v1[1]}), d = gelu_pk((f32x2){v1[2], v1[3]});
                        v0 = (f32x4){a.x, a.y, b.x, b.y}; v1 = (f32x4){c.x, c.y, d.x, d.y}; }
                    v0 = v0 * sc; v1 = v1 * sc; u32x4 w; w.x = cvt_pk_bf16(v0[0], v0[1]); w.y = cvt_pk_bf16(v0[2], v0[3]); w.z = cvt_pk_bf16(v1[0], v1[1]); w.w = cvt_pk_bf16(v1[2], v1[3]);
                    *(u32x4*)(rowp + bj * HALF) = w; } }
    }
};
template <class Epi, class Sched, bool ALIGN_EPI = false, bool SP2 = false>
__device__ __forceinline__ void gemm_phase(PG8_LAS unsigned char* lds, const Gemm g, const Sched& S, const Epi& E) {
    const int tid = threadIdx.x, wid = __builtin_amdgcn_readfirstlane(tid >> 6), lane = tid & 63, wr = wid >> 2, wc = wid & 3, fr = lane & 15, fq = lane >> 4;
    const int K = g.K, nt = K / BK;
    unsigned voffA[2], voffB[2];
#pragma unroll
    for (int i = 0; i < 2; ++i) { int R, C; stage_rc(tid * 16 + i * 8192, R, C); const int Rb = Epi::PERM ? ((R & ~31) + perm32(R & 31)) : R;
        voffA[i] = (unsigned)(R * K + C) * 2u; voffB[i] = (unsigned)(Rb * K + C) * 2u; }
    const size_t kstep = (size_t)(BK * 2);
    const size_t hstep = (size_t)HALF * K * 2;
    const size_t tstep = 2 * hstep;
    const unsigned ldsw = (unsigned)wid * 1024u;
    const int aoff = lds_byte(wr * 64 + fr, fq * 8), boff = lds_byte(wc * 32 + fr, fq * 8);
#define PG8_SA(b, h) (((b) * 2 + (h)) * HTB)
#define PG8_SB(b, h) ((4 + (b) * 2 + (h)) * HTB)
#define PG8_STAGE(bufoff, gbase, voff) do { _Pragma("unroll") for (int _i = 0; _i < 2; ++_i) \
        __builtin_amdgcn_global_load_lds((const unsigned*)((const char*)(gbase) + (voff)[_i]), (PG8_LAS unsigned*)(lds + (bufoff) + ldsw + _i * 8192), 16, 0, 0); } while (0)
#define PG8_LDA(dst, b, h) do { _Pragma("unroll") for (int m = 0; m < 4; ++m) _Pragma("unroll") for (int k = 0; k < 2; ++k) dst[m][k] = *(const PG8_LAS bf16x8*)(lds + PG8_SA(b, h) + aoff + m * 2048 + k * 1024); } while (0)
#define PG8_LDB(dst, b, h) do { _Pragma("unroll") for (int n = 0; n < 2; ++n) _Pragma("unroll") for (int k = 0; k < 2; ++k) dst[n][k] = *(const PG8_LAS bf16x8*)(lds + PG8_SB(b, h) + boff + n * 2048 + k * 1024); } while (0)
#define PG8_MMA(ai, bj, At, Bt) do { __builtin_amdgcn_s_setprio(1); _Pragma("unroll") for (int m = 0; m < 4; ++m) _Pragma("unroll") for (int n = 0; n < 2; ++n) _Pragma("unroll") for (int k = 0; k < 2; ++k) \
        acc[ai][bj][m][n] = __builtin_amdgcn_mfma_f32_16x16x32_bf16(Bt[n][k], At[m][k], acc[ai][bj][m][n], 0, 0, 0); __builtin_amdgcn_s_setprio(0); } while (0)
#define PG8_WAIT_V(n) asm volatile("s_waitcnt vmcnt(" #n ")" ::: "memory")
#define PG8_WAIT_L(n) asm volatile("s_waitcnt lgkmcnt(" #n ")" ::: "memory")
#define PG8_BAR __builtin_amdgcn_s_barrier()
#define PG8_SCHED __builtin_amdgcn_sched_barrier(0)
    Unit cur, nxt; int ui = 0;
    if (!S.next(0, cur)) return;
    f32x4 acc[2][2][4][2];
#pragma unroll
    for (int a = 0; a < 2; ++a)
#pragma unroll
        for (int b = 0; b < 2; ++b)
#pragma unroll
            for (int m = 0; m < 4; ++m)
#pragma unroll
                for (int n = 0; n < 2; ++n) acc[a][b][m][n] = (f32x4){0.f, 0.f, 0.f, 0.f};
    bf16x8 At[4][2], B0[2][2], B1[2][2];
    const char* cA = (const char*)g.A + (size_t)cur.pm * tstep; const char* cB = (const char*)g.Bt + (size_t)cur.pn * tstep;
    S.a_ready(cur);
    if constexpr (SP2) {
        PG8_STAGE(PG8_SB(0, 0), cB, voffB); PG8_STAGE(PG8_SB(0, 1), cB + hstep, voffB); PG8_STAGE(PG8_SA(0, 0), cA, voffA); PG8_STAGE(PG8_SA(0, 1), cA + hstep, voffA);
        if (wr == 1) PG8_BAR;
        PG8_WAIT_V(2); PG8_BAR;
        PG8_STAGE(PG8_SB(1, 0), cB + kstep, voffB); PG8_STAGE(PG8_SA(1, 0), cA + kstep, voffA); PG8_STAGE(PG8_SB(1, 1), cB + hstep + kstep, voffB);
        PG8_WAIT_V(6); PG8_BAR;
    } else {
        PG8_STAGE(PG8_SB(0, 0), cB, voffB); PG8_STAGE(PG8_SA(0, 0), cA, voffA); PG8_STAGE(PG8_SB(0, 1), cB + hstep, voffB); PG8_STAGE(PG8_SA(0, 1), cA + hstep, voffA);
        if (wr == 1) PG8_BAR;
        PG8_WAIT_V(4); PG8_BAR;
        PG8_STAGE(PG8_SB(1, 0), cB + kstep, voffB); PG8_STAGE(PG8_SA(1, 0), cA + kstep, voffA); PG8_STAGE(PG8_SB(1, 1), cB + hstep + kstep, voffB);
        PG8_WAIT_V(6); PG8_BAR;
    }
    for (;;) {
        const bool has_next = S.next(ui + 1, nxt);
        const char* nA = has_next ? (const char*)g.A + (size_t)nxt.pm * tstep : cA; const char* nB = has_next ? (const char*)g.Bt + (size_t)nxt.pn * tstep : cB;
_Pragma("unroll 1")
        for (int t = 0; t < nt; t += 2) {
            const bool last = (t == nt - 2);
            const char* a1 = cA + (size_t)(t + 1) * kstep;
            const char* a2 = last ? nA : cA + (size_t)(t + 2) * kstep; const char* b2 = last ? nB : cB + (size_t)(t + 2) * kstep;
            const char* a3 = a2 + kstep; const char* b3 = b2 + kstep;
            if (last && has_next) S.a_ready(nxt);
            if constexpr (SP2) {
            PG8_LDB(B0, 0, 0); PG8_LDB(B1, 0, 1); PG8_SCHED; PG8_LDA(At, 0, 0); PG8_STAGE(PG8_SA(1, 1), a1 + hstep, voffA);
            PG8_WAIT_V(8); PG8_WAIT_L(0); PG8_BAR; PG8_MMA(0, 0, At, B0); PG8_MMA(0, 1, At, B1); PG8_BAR; PG8_SCHED;
            PG8_LDA(At, 0, 1); PG8_STAGE(PG8_SB(0, 0), b2, voffB); PG8_STAGE(PG8_SB(0, 1), b2 + hstep, voffB); PG8_STAGE(PG8_SA(0, 0), a2, voffA);
            PG8_WAIT_V(8); PG8_WAIT_L(0); PG8_BAR; PG8_MMA(1, 0, At, B0); PG8_MMA(1, 1, At, B1); PG8_BAR; PG8_SCHED;
            PG8_LDB(B0, 1, 0); PG8_LDB(B1, 1, 1); PG8_SCHED; PG8_LDA(At, 1, 0); PG8_STAGE(PG8_SA(0, 1), a2 + hstep, voffA);
            PG8_WAIT_V(8); PG8_WAIT_L(0); PG8_BAR; PG8_MMA(0, 0, At, B0); PG8_MMA(0, 1, At, B1); PG8_BAR; PG8_SCHED;
            PG8_LDA(At, 1, 1); PG8_STAGE(PG8_SB(1, 0), b3, voffB); PG8_STAGE(PG8_SB(1, 1), b3 + hstep, voffB); PG8_STAGE(PG8_SA(1, 0), a3, voffA);
            PG8_WAIT_V(8); PG8_WAIT_L(0); PG8_BAR; PG8_MMA(1, 0, At, B0); PG8_MMA(1, 1, At, B1); PG8_BAR; PG8_SCHED;
            } else {
            PG8_LDB(B0, 0, 0); PG8_SCHED; PG8_LDA(At, 0, 0); PG8_STAGE(PG8_SA(1, 1), a1 + hstep, voffA);
            PG8_WAIT_L(8); PG8_BAR; PG8_WAIT_L(0); PG8_MMA(0, 0, At, B0); PG8_BAR; PG8_SCHED;
            PG8_LDB(B1, 0, 1); PG8_STAGE(PG8_SB(0, 0), b2, voffB);
            PG8_BAR; PG8_WAIT_L(0); PG8_MMA(0, 1, At, B1); PG8_BAR;
            PG8_LDA(At, 0, 1); PG8_STAGE(PG8_SA(0, 0), a2, voffA);
            PG8_BAR; PG8_WAIT_L(0); PG8_MMA(1, 0, At, B0); PG8_BAR; PG8_SCHED;
            PG8_STAGE(PG8_SB(0, 1), b2 + hstep, voffB);
            PG8_WAIT_V(6); PG8_BAR; PG8_MMA(1, 1, At, B1); PG8_BAR;
            PG8_LDB(B0, 1, 0); PG8_SCHED; PG8_LDA(At, 1, 0); PG8_STAGE(PG8_SA(0, 1), a2 + hstep, voffA);
            PG8_WAIT_L(8); PG8_BAR; PG8_WAIT_L(0); PG8_MMA(0, 0, At, B0); PG8_BAR; PG8_SCHED;
            PG8_LDB(B1, 1, 1); PG8_STAGE(PG8_SB(1, 0), b3, voffB);
            PG8_BAR; PG8_WAIT_L(0); PG8_MMA(0, 1, At, B1); PG8_BAR;
            PG8_LDA(At, 1, 1); PG8_STAGE(PG8_SA(1, 0), a3, voffA);
            PG8_BAR; PG8_WAIT_L(0); PG8_MMA(1, 0, At, B0); PG8_BAR; PG8_SCHED;
            PG8_STAGE(PG8_SB(1, 1), b3 + hstep, voffB);
            PG8_WAIT_V(6); PG8_BAR; PG8_MMA(1, 1, At, B1); PG8_BAR;
            }
        }
        if constexpr (ALIGN_EPI) { if (wr == 0) PG8_BAR; }
        if constexpr (!Epi::AFTER_DRAIN) { E(acc, cur, wr, wc, fr, fq); S.done(cur); }
        if (!has_next) break;
#pragma unroll
        for (int a = 0; a < 2; ++a)
#pragma unroll
            for (int b = 0; b < 2; ++b)
#pragma unroll
                for (int m = 0; m < 4; ++m)
#pragma unroll
                    for (int n = 0; n < 2; ++n) acc[a][b][m][n] = (f32x4){0.f, 0.f, 0.f, 0.f};
        cur = nxt; cA = nA; cB = nB; ++ui;
        if constexpr (ALIGN_EPI) { if (wr == 1) PG8_BAR; }
    }
    PG8_WAIT_V(0);
    if constexpr (!ALIGN_EPI) { if (wr == 0) PG8_BAR; }
    PG8_BAR;
    if constexpr (Epi::AFTER_DRAIN) { E.fused(acc, cur, wr, wc, fr, fq, lds, wid, lane); S.done(cur); }
#undef PG8_SA
#undef PG8_SB
#undef PG8_STAGE
#undef PG8_LDA
#undef PG8_LDB
#undef PG8_MMA
#undef PG8_WAIT_V
#undef PG8_WAIT_L
#undef PG8_BAR
#undef PG8_SCHED
}
}

#include <hip/hip_cooperative_groups.h>
namespace cg = cooperative_groups;

#ifndef MK_ONE_LAUNCH
#define MK_ONE_LAUNCH 1
#endif

#define LAS __attribute__((address_space(3)))
typedef unsigned short bf16;
typedef float f32x4 __attribute__((ext_vector_type(4)));
typedef float f32x16 __attribute__((ext_vector_type(16)));
typedef unsigned u32x4 __attribute__((ext_vector_type(4)));
typedef unsigned u32x2 __attribute__((ext_vector_type(2)));
typedef short bf16x8 __attribute__((ext_vector_type(8)));
typedef short s16x4 __attribute__((ext_vector_type(4)));

constexpr int NWAVES = 8;
constexpr int SEQ = 2048, DM = 1024, NB = 48, T = NB * SEQ;
constexpr int ZW = 2816, GW = 2048, FF = 2816;
constexpr int N1 = ZW + GW;
constexpr float EPS = 1e-6f;
constexpr int LDS_BYTES = 147456, RING_BYTES = 131072;

constexpr size_t MiB = 1u << 20;
constexpr size_t WS_W1T = 1 * MiB, WS_WPT = 11 * MiB, WS_WUAT = 12 * MiB, WS_WOT = 13 * MiB, WS_WGUT = 15 * MiB, WS_WDT = 26 * MiB;
constexpr size_t WS_ROPE = 32 * MiB, WS_SSQ2 = 34 * MiB;
constexpr size_t WS_XB = 48 * MiB;
constexpr size_t WS_POOLED = WS_XB, WS_MERGED = WS_XB + 96 * MiB;
constexpr size_t WS_Z = 240 * MiB;
constexpr size_t WS_END = 768 * MiB;

__device__ __forceinline__ unsigned f2bf(float f) { unsigned u = __builtin_bit_cast(unsigned, f); return (u + 0x7fffu + ((u >> 16) & 1u)) >> 16; }
__device__ __forceinline__ unsigned pk2(float lo, float hi) { return f2bf(lo) | (f2bf(hi) << 16); }
__device__ __forceinline__ float bflo(unsigned w) { return __builtin_bit_cast(float, w << 16); }
__device__ __forceinline__ float bfhi(unsigned w) { return __builtin_bit_cast(float, w & 0xffff0000u); }
__device__ __forceinline__ float wave_sum(float v) {
#pragma unroll
    for (int o = 1; o < 64; o <<= 1) v += __shfl_xor(v, o);
    return v;
}
__device__ __forceinline__ float sigmoidf_(float x) { return 1.0f / (1.0f + __expf(-x)); }

namespace ep {
using pg8::Unit; using pg8::cvt_pk_bf16;
constexpr int BM = 256, HALF = 128;

__device__ __forceinline__ u32x4 pack8(const f32x4 v0, const f32x4 v1) {
    u32x4 w; w.x = cvt_pk_bf16(v0[0], v0[1]); w.y = cvt_pk_bf16(v0[2], v0[3]); w.z = cvt_pk_bf16(v1[0], v1[1]); w.w = cvt_pk_bf16(v1[2], v1[3]); return w;
}
__device__ __forceinline__ void unpack8(const u32x4 w, f32x4& v0, f32x4& v1) {
    v0 = (f32x4){bflo(w.x), bfhi(w.x), bflo(w.y), bfhi(w.y)}; v1 = (f32x4){bflo(w.z), bfhi(w.z), bflo(w.w), bfhi(w.w)};
}

struct EpiZG {
    static constexpr bool PERM = true, AFTER_DRAIN = false;
    bf16* Z; bf16* G; const float* bias; const float* rope;
    __device__ __forceinline__ void operator()(const f32x4 (&acc)[2][2][4][2], const Unit& u, int wr, int wc, int fr, int fq) const {
        const int row0 = u.pm * BM + wr * 64 + fr;
        const int cl = wc * 32 + 8 * fq;
        if (u.pn >= 11) {
            const int gc0 = (u.pn - 11) * BM + cl;
            f32x4 bv[2][2];
#pragma unroll
            for (int bj = 0; bj < 2; ++bj)
#pragma unroll
                for (int n = 0; n < 2; ++n) bv[bj][n] = *(const f32x4*)(bias + gc0 + bj * HALF + 4 * n);
#pragma unroll
            for (int ai = 0; ai < 2; ++ai)
#pragma unroll
                for (int m = 0; m < 4; ++m) { bf16* rowp = G + (size_t)(row0 + ai * HALF + m * 16) * GW + gc0;
#pragma unroll
                    for (int bj = 0; bj < 2; ++bj) { f32x4 v0 = acc[ai][bj][m][0] + bv[bj][0], v1 = acc[ai][bj][m][1] + bv[bj][1];
#pragma unroll
                        for (int j = 0; j < 4; ++j) { v0[j] = sigmoidf_(v0[j]); v1[j] = sigmoidf_(v1[j]); }
                        *(u32x4*)(rowp + bj * HALF) = pack8(v0, v1); }
                    asm volatile("" ::: "memory"); }
        } else {
            const int zc0 = u.pn * BM + cl;
            const bool rope_tile = (u.pn >= 2 && u.pn < 8);
            const float sc = (u.pn >= 2 && u.pn < 5) ? 0.125f : 1.0f;
            if (rope_tile && !(wc & 1)) {
                const float sgn = (fq == 0) ? -1.0f : 1.0f; const bool act = fq < 2;
#pragma unroll
                for (int ai = 0; ai < 2; ++ai)
#pragma unroll
                    for (int m = 0; m < 4; ++m) { const int row = row0 + ai * HALF + m * 16; const f32x4* tp = (const f32x4*)(rope + (row & (SEQ - 1)) * 16);
                        const f32x4 c0 = tp[0], c1 = tp[1], s0 = tp[2] * sgn, s1 = tp[3] * sgn;
                        bf16* rowp = Z + (size_t)row * ZW + zc0;
#pragma unroll
                        for (int bj = 0; bj < 2; ++bj) { f32x4 v0 = acc[ai][bj][m][0], v1 = acc[ai][bj][m][1], p0, p1;
#pragma unroll
                            for (int j = 0; j < 4; ++j) { p0[j] = __shfl_xor(v0[j], 16); p1[j] = __shfl_xor(v1[j], 16); }
                            if (act) { v0 = v0 * c0 + p0 * s0; v1 = v1 * c1 + p1 * s1; }
                            v0 = v0 * sc; v1 = v1 * sc;
                            *(u32x4*)(rowp + bj * HALF) = pack8(v0, v1); }
                        asm volatile("" ::: "memory"); }
            } else {
#pragma unroll
                for (int ai = 0; ai < 2; ++ai)
#pragma unroll
                    for (int m = 0; m < 4; ++m) { bf16* rowp = Z + (size_t)(row0 + ai * HALF + m * 16) * ZW + zc0;
#pragma unroll
                        for (int bj = 0; bj < 2; ++bj) *(u32x4*)(rowp + bj * HALF) = pack8(acc[ai][bj][m][0] * sc, acc[ai][bj][m][1] * sc); }
            }
        }
    }
};

template <int SECOND> struct EpiGate {
    static constexpr bool PERM = true, AFTER_DRAIN = false;
    bf16* MB; const bf16* G;
    __device__ __forceinline__ void operator()(const f32x4 (&acc)[2][2][4][2], const Unit& u, int wr, int wc, int fr, int fq) const {
        const int row0 = u.pm * BM + wr * 64 + fr, col0 = u.pn * BM + wc * 32 + 8 * fq;
#pragma unroll
        for (int ai = 0; ai < 2; ++ai)
#pragma unroll
            for (int m = 0; m < 4; ++m) { const size_t row = (size_t)(row0 + ai * HALF + m * 16);
#pragma unroll
                for (int bj = 0; bj < 2; ++bj) { const int c = col0 + bj * HALF;
                    const u32x4 gw = *(const u32x4*)(G + row * GW + SECOND * DM + c); f32x4 g0, g1; unpack8(gw, g0, g1);
                    f32x4 v0 = acc[ai][bj][m][0] * g0, v1 = acc[ai][bj][m][1] * g1;
                    if (SECOND) { const u32x4 tw = *(const u32x4*)(MB + row * DM + c); f32x4 t0, t1; unpack8(tw, t0, t1); v0 += t0; v1 += t1; }
                    *(u32x4*)(MB + row * DM + c) = pack8(v0, v1); }
                asm volatile("" ::: "memory"); }
    }
};

template <int FIRST> struct EpiRes {
    static constexpr bool PERM = true, AFTER_DRAIN = false;
    const float* base_lo; const float* base_hi; float* out; bf16* XB_; float* ssq;
    __device__ __forceinline__ void operator()(const f32x4 (&acc)[2][2][4][2], const Unit& u, int wr, int wc, int fr, int fq) const {
        const int row0 = u.pm * BM + wr * 64 + fr, col0 = u.pn * BM + wc * 32 + 8 * fq;
        const float* base = (u.pm < 256) ? base_lo : base_hi;
#pragma unroll
        for (int ai = 0; ai < 2; ++ai)
#pragma unroll
            for (int m = 0; m < 4; ++m) { const size_t row = (size_t)(row0 + ai * HALF + m * 16); float q = 0.f;
#pragma unroll
                for (int bj = 0; bj < 2; ++bj) { const size_t off = row * DM + col0 + bj * HALF;
                    const f32x4 b0 = *(const f32x4*)(base + off), b1 = *(const f32x4*)(base + off + 4);
                    const f32x4 v0 = acc[ai][bj][m][0] + b0, v1 = acc[ai][bj][m][1] + b1;
                    *(f32x4*)(out + off) = v0; *(f32x4*)(out + off + 4) = v1;
                    if (FIRST) { *(u32x4*)(XB_ + off) = pack8(v0, v1);
                        q += (v0[0] * v0[0] + v0[1] * v0[1]) + (v0[2] * v0[2] + v0[3] * v0[3]) + (v1[0] * v1[0] + v1[1] * v1[1]) + (v1[2] * v1[2] + v1[3] * v1[3]); } }
                if (FIRST) { q += __shfl_xor(q, 16); q += __shfl_xor(q, 32); if (fq == 0) ssq[row * 16 + u.pn * 4 + wc] = q; }
                asm volatile("" ::: "memory"); }
    }
};

struct EpiSwiGLU {
    static constexpr bool PERM = true, AFTER_DRAIN = false;
    bf16* ACT; const float* ssq;
    __device__ __forceinline__ void operator()(const f32x4 (&acc)[2][2][4][2], const Unit& u, int wr, int wc, int fr, int fq) const {
        const int row0 = u.pm * BM + wr * 64 + fr, col0 = u.pn * HALF + wc * 32 + 8 * fq;
#pragma unroll
        for (int ai = 0; ai < 2; ++ai)
#pragma unroll
            for (int m = 0; m < 4; ++m) { const size_t row = (size_t)(row0 + ai * HALF + m * 16);
                const f32x4* sp = (const f32x4*)(ssq + row * 16); const f32x4 s4 = (sp[0] + sp[1]) + (sp[2] + sp[3]);
                const float rstd = 1.0f / sqrtf(((s4[0] + s4[1]) + (s4[2] + s4[3])) * (1.0f / DM) + EPS);
                f32x4 g0 = acc[ai][0][m][0] * rstd, g1 = acc[ai][0][m][1] * rstd, u0 = acc[ai][1][m][0] * rstd, u1 = acc[ai][1][m][1] * rstd;
#pragma unroll
                for (int j = 0; j < 4; ++j) { g0[j] = g0[j] * sigmoidf_(g0[j]) * u0[j]; g1[j] = g1[j] * sigmoidf_(g1[j]) * u1[j]; }
                *(u32x4*)(ACT + row * FF + col0) = pack8(g0, g1);
                asm volatile("" ::: "memory"); }
    }
};
}

__device__ __forceinline__ void p0_transpose_item(const float* W, int K, int N, bf16* WT, int mode, int row_off, const float* gain, LAS float* scr, int item, int lane) {
    const int nblk = N / 32, kb = item / nblk, nb = item % nblk, k0 = 64 * kb, n0 = 32 * nb;
#pragma unroll 8
    for (int i = 0; i < 32; ++i) { const int kk = 2 * i + (lane >> 5); const float g = gain ? gain[k0 + kk] : 1.0f; scr[kk * 33 + (lane & 31)] = W[(size_t)(k0 + kk) * N + n0 + (lane & 31)] * g; }
    asm volatile("s_waitcnt lgkmcnt(0)" ::: "memory");
    const int c = lane & 7;
#pragma unroll
    for (int j = 0; j < 4; ++j) { const int n = (lane >> 3) + 8 * j; const LAS float* s = scr + (8 * c) * 33 + n;
        u32x4 o; o.x = pk2(s[0 * 33], s[1 * 33]); o.y = pk2(s[2 * 33], s[3 * 33]); o.z = pk2(s[4 * 33], s[5 * 33]); o.w = pk2(s[6 * 33], s[7 * 33]);
        const int col = n0 + n; const int orow = (mode ? (((col >> 7) << 8) + (col & 127)) : col) + row_off;
        *(u32x4*)(WT + (size_t)orow * K + k0 + 8 * c) = o; }
    asm volatile("s_waitcnt lgkmcnt(0)" ::: "memory");
}

#define MFMA32(a, b, c) __builtin_amdgcn_mfma_f32_32x32x16_bf16((a), (b), (c), 0, 0, 0)
__device__ __forceinline__ int crow(int reg, int h) { return (reg & 3) + 8 * (reg >> 2) + 4 * h; }
__device__ __forceinline__ bf16x8 pack_step(const f32x16& x, int s) {
    u32x4 p;
    asm volatile("v_cvt_pk_bf16_f32 %0, %4, %5\n\tv_cvt_pk_bf16_f32 %1, %6, %7\n\tv_cvt_pk_bf16_f32 %2, %8, %9\n\tv_cvt_pk_bf16_f32 %3, %10, %11\n\ts_nop 1"
                 : "=&v"(p[0]), "=&v"(p[1]), "=&v"(p[2]), "=&v"(p[3])
                 : "v"(x[8 * s]), "v"(x[8 * s + 1]), "v"(x[8 * s + 2]), "v"(x[8 * s + 3]), "v"(x[8 * s + 4]), "v"(x[8 * s + 5]), "v"(x[8 * s + 6]), "v"(x[8 * s + 7]));
    return __builtin_bit_cast(bf16x8, p);
}
__device__ __forceinline__ void tr_read4(unsigned a, s16x4& lo0, s16x4& hi0, s16x4& lo1, s16x4& hi1) {
    asm volatile("ds_read_b64_tr_b16 %0, %4\n\tds_read_b64_tr_b16 %1, %4 offset:1152\n\tds_read_b64_tr_b16 %2, %4 offset:64\n\tds_read_b64_tr_b16 %3, %4 offset:1216\n\ts_waitcnt lgkmcnt(0)"
                 : "=&v"(lo0), "=&v"(hi0), "=&v"(lo1), "=&v"(hi1) : "v"(a) : "memory");
}
constexpr int AT_OPITCH = 144, AT_LSE_OFF = 512 * AT_OPITCH, AT_VST_OFF = AT_LSE_OFF + 2048, AT_VPITCH = 144, AT_VST_BYTES = 32 * AT_VPITCH;
static_assert(AT_VST_OFF + NWAVES * AT_VST_BYTES <= RING_BYTES, "attention LDS");
static_assert(8 * AT_VPITCH == 1152, "tr_read4 offsets");

__device__ __forceinline__ void attn_unit(LAS unsigned char* lds, const bf16* Z, bf16* MERGED, int b, int hq, int chunk, int wid, int lane, int tid) {
    const int r32 = lane & 31, h = lane >> 5;
    const bf16* zb = Z + (size_t)b * SEQ * ZW;
    LAS unsigned char* vst = lds + AT_VST_OFF + wid * AT_VST_BYTES;
    LAS float* LSE = (LAS float*)(lds + AT_LSE_OFF);
    const float NEG = -INFINITY;
#pragma unroll 1
    for (int g = 0; g < 3; ++g) {
        const int sh = 2 * g, d = 1 << sh, bpr = 16 >> sh, n = SEQ >> sh, hg = 4 * g + hq;
#pragma unroll 1
        for (int wbi = 0; wbi < 2; ++wbi) {
            const int wb = wid * 2 + wbi, r = wb / bpr, q0 = chunk * (512 >> sh) + 32 * (wb % bpr);
            const int qtok = (q0 + r32) * d + r;
            bf16x8 qf[4];
            { const u32x4* qp = (const u32x4*)(zb + (size_t)qtok * ZW + 512 + hg * 64 + 8 * h);
#pragma unroll
              for (int s = 0; s < 4; ++s) qf[s] = __builtin_bit_cast(bf16x8, qp[2 * s]); }
            f32x16 S[5];
#pragma unroll
            for (int c = 0; c < 5; ++c) {
                const int j0 = q0 - 64 + 32 * c;
                if (j0 >= 0 && j0 < n) {
                    const int ktok = (j0 + r32) * d + r;
                    const u32x4* kp = (const u32x4*)(zb + (size_t)ktok * ZW + 1280 + hg * 64 + 8 * h);
                    bf16x8 kf[4];
#pragma unroll
                    for (int s = 0; s < 4; ++s) kf[s] = __builtin_bit_cast(bf16x8, kp[2 * s]);
                    f32x16 a;
#pragma unroll
                    for (int i = 0; i < 16; ++i) a[i] = 0.f;
#pragma unroll
                    for (int s = 0; s < 4; ++s) a = MFMA32(kf[s], qf[s], a);
                    if (c == 0) {
#pragma unroll
                        for (int i = 0; i < 16; ++i) if (crow(i, h) < r32) a[i] = NEG;
                    }
                    if (c == 4) {
#pragma unroll
                        for (int i = 0; i < 16; ++i) if (crow(i, h) > r32) a[i] = NEG;
                    }
                    S[c] = a;
                } else {
#pragma unroll
                    for (int i = 0; i < 16; ++i) S[c][i] = NEG;
                }
            }
            float mx = NEG;
#pragma unroll
            for (int c = 0; c < 5; ++c)
#pragma unroll
                for (int i = 0; i < 16; ++i) mx = fmaxf(mx, S[c][i]);
            mx = fmaxf(mx, __shfl_xor(mx, 32));
            float den = 0.f;
#pragma unroll
            for (int c = 0; c < 5; ++c)
#pragma unroll
                for (int i = 0; i < 16; ++i) { const float p = __expf(S[c][i] - mx); S[c][i] = p; den += p; }
            den += __shfl_xor(den, 32);
            f32x16 O0, O1;
#pragma unroll
            for (int i = 0; i < 16; ++i) { O0[i] = 0.f; O1[i] = 0.f; }
            const unsigned trbase = (unsigned)(size_t)vst + (4 * h + ((lane & 15) >> 2)) * AT_VPITCH + 32 * ((lane >> 4) & 1) + 8 * (lane & 3);
#pragma unroll
            for (int c = 0; c < 5; ++c) {
                const int j0 = q0 - 64 + 32 * c;
                if (j0 >= 0 && j0 < n) {
                    const int vtok = (j0 + (lane >> 1)) * d + r;
                    const u32x4* vp = (const u32x4*)(zb + (size_t)vtok * ZW + 2048 + hg * 64 + (lane & 1) * 32);
                    u32x4 v4[4];
#pragma unroll
                    for (int i = 0; i < 4; ++i) v4[i] = vp[i];
                    LAS u32x4* vw = (LAS u32x4*)(vst + (lane >> 1) * AT_VPITCH + (lane & 1) * 64);
#pragma unroll
                    for (int i = 0; i < 4; ++i) vw[i] = v4[i];
                    asm volatile("s_waitcnt lgkmcnt(0)" ::: "memory");
#pragma unroll
                    for (int s = 0; s < 2; ++s) {
                        const bf16x8 pf = pack_step(S[c], s);
                        s16x4 lo0, hi0, lo1, hi1;
                        tr_read4(trbase + 16 * s * AT_VPITCH, lo0, hi0, lo1, hi1);
                        const bf16x8 va0 = __builtin_shufflevector(lo0, hi0, 0, 1, 2, 3, 4, 5, 6, 7), va1 = __builtin_shufflevector(lo1, hi1, 0, 1, 2, 3, 4, 5, 6, 7);
                        O0 = MFMA32(va0, pf, O0); O1 = MFMA32(va1, pf, O1);
                    }
                }
            }
            const float inv = 1.0f / den, lse = mx + __logf(den);
            const int tokidx = qtok - chunk * 512;
            LAS unsigned char* orow = lds + tokidx * AT_OPITCH + 8 * h;
            float wo = 0.f, wn = inv, lnew = lse;
            if (g > 0) { const float lold = LSE[tokidx]; const float mxl = fmaxf(lold, lse); lnew = mxl + __logf(__expf(lold - mxl) + __expf(lse - mxl)); wo = __expf(lold - lnew); wn = __expf(lse - lnew) * inv; }
#pragma unroll
            for (int dt = 0; dt < 2; ++dt)
#pragma unroll
                for (int a4 = 0; a4 < 4; ++a4) {
                    LAS u32x2* p = (LAS u32x2*)(orow + dt * 64 + a4 * 16);
                    f32x4 v;
#pragma unroll
                    for (int j = 0; j < 4; ++j) v[j] = (dt ? O1[4 * a4 + j] : O0[4 * a4 + j]) * wn;
                    if (g > 0) { const u32x2 ow = *p; v[0] += wo * bflo(ow.x); v[1] += wo * bfhi(ow.x); v[2] += wo * bflo(ow.y); v[3] += wo * bfhi(ow.y); }
                    u32x2 nw; nw.x = pk2(v[0], v[1]); nw.y = pk2(v[2], v[3]); *p = nw;
                }
            if (h == 0) LSE[tokidx] = lnew;
        }
        __syncthreads();
    }
    bf16* mo = MERGED + ((size_t)b * SEQ + chunk * 512) * 256 + hq * 64;
#pragma unroll
    for (int it = 0; it < 8; ++it) { const int idx = tid + 512 * it, tok = idx >> 3, pc = idx & 7;
        const u32x4 w = *(const LAS u32x4*)(lds + tok * AT_OPITCH + pc * 16);
        *(u32x4*)(mo + (size_t)tok * 256 + pc * 8) = w; }
    __syncthreads();
}

__device__ __forceinline__ void pool_unit(LAS unsigned char* lds, const bf16* Z, bf16* POOLED, int b, int t0, int wid, int lane, int tid) {
    const bf16* zb = Z + (size_t)b * SEQ * ZW;
    for (int rr = wid; rr < 80; rr += NWAVES) { const int t = t0 - 8 + rr;
        if (t >= 0 && t < SEQ) *(LAS u32x4*)(lds + rr * 1024 + lane * 16) = *(const u32x4*)(zb + (size_t)t * ZW + lane * 8); }
    __syncthreads();
#pragma unroll 1
    for (int k = 0; k < 8; ++k) { const int idx = tid + 512 * k, tl = idx >> 6, cu = idx & 63, t = t0 + tl, hw = 1 << (cu >> 4);
        const int lo = (t - hw) < 0 ? 0 : (t - hw), hi = (t + hw) > SEQ ? SEQ : (t + hw);
        f32x4 s0 = (f32x4){0.f, 0.f, 0.f, 0.f}, s1 = s0;
        for (int j = lo; j < hi; ++j) { const u32x4 w = *(const LAS u32x4*)(lds + (j - t0 + 8) * 1024 + cu * 16); f32x4 a0, a1; ep::unpack8(w, a0, a1); s0 += a0; s1 += a1; }
        const float ic = 1.0f / (float)(hi - lo);
        const u32x4 w = *(const LAS u32x4*)(lds + (tl + 8) * 1024 + cu * 16); f32x4 a0, a1; ep::unpack8(w, a0, a1);
        s0 = s0 * ic - a0; s1 = s1 * ic - a1;
        u32x4 o; o.x = pk2(s0[0], s0[1]); o.y = pk2(s0[2], s0[3]); o.z = pk2(s1[0], s1[1]); o.w = pk2(s1[2], s1[3]);
        *(u32x4*)(POOLED + ((size_t)b * SEQ + t) * 512 + cu * 8) = o; }
    __syncthreads();
}

struct Args { const float* in[16]; float* out; unsigned char* ws; int ph_lo, ph_hi; };

__global__ void __launch_bounds__(NWAVES * 64, 2) mk_fwd(Args args) {
    extern __shared__ __attribute__((aligned(16))) unsigned char lds_raw[];
    LAS unsigned char* lds = (LAS unsigned char*)lds_raw;
    cg::grid_group grid = cg::this_grid();
    const int tid = threadIdx.x, lane = tid & 63, wid = __builtin_amdgcn_readfirstlane(tid >> 6);
    const int G = gridDim.x, bx = blockIdx.x;
    const int vcu = (G % 8 == 0) ? (bx % 8) * (G / 8) + bx / 8 : bx;
    unsigned char* ws = args.ws;
    bf16* W1T = (bf16*)(ws + WS_W1T); bf16* WPT = (bf16*)(ws + WS_WPT); bf16* WUAT = (bf16*)(ws + WS_WUAT); bf16* WOT = (bf16*)(ws + WS_WOT);
    bf16* WGUT = (bf16*)(ws + WS_WGUT); bf16* WDT = (bf16*)(ws + WS_WDT);
    float* ROPE = (float*)(ws + WS_ROPE); float* SSQ2 = (float*)(ws + WS_SSQ2);
    bf16* XB = (bf16*)(ws + WS_XB); bf16* POOLED = (bf16*)(ws + WS_POOLED); bf16* MERGED = (bf16*)(ws + WS_MERGED);
    bf16* Z = (bf16*)(ws + WS_Z); bf16* MB = Z; bf16* ACT = Z;
    float* OUT = args.out; bf16* GB = (bf16*)args.out;
    const int lo = args.ph_lo, hi = args.ph_hi;
#ifndef PH_MASK
#define PH_MASK 255
#endif
#define IN(k) (((PH_MASK >> (k)) & 1) && lo <= (k) && (k) < hi)
#define SEAM(k) do { if (IN(k) && IN((k) + 1)) grid.sync(); } while (0)

    if (IN(0)) {
        LAS float* scr = (LAS float*)(lds + wid * 16384);
        const int gw = vcu * NWAVES + wid, NGW = G * NWAVES;
        constexpr int I_IN = (DM / 64) * (ZW / 32), I_G = (DM / 64) * (GW / 32), I_UA = (256 / 64) * (DM / 32), I_O = (DM / 64) * (DM / 32), I_F = (DM / 64) * (FF / 32), I_D = (FF / 64) * (DM / 32);
        constexpr int NITEMS = I_IN + I_G + I_UA + I_O + 2 * I_F + I_D;
        for (int it = gw; it < NITEMS; it += NGW) {
            int r = it;
            if (r < I_IN) { p0_transpose_item(args.in[3], DM, ZW, W1T, 0, 0, args.in[2], scr, r, lane); continue; } r -= I_IN;
            if (r < I_G) { p0_transpose_item(args.in[8], DM, GW, W1T, 0, ZW, args.in[2], scr, r, lane); continue; } r -= I_G;
            if (r < I_UA) { p0_transpose_item(args.in[7], 256, DM, WUAT, 0, 0, nullptr, scr, r, lane); continue; } r -= I_UA;
            if (r < I_O) { p0_transpose_item(args.in[10], DM, DM, WOT, 0, 0, nullptr, scr, r, lane); continue; } r -= I_O;
            if (r < I_F) { p0_transpose_item(args.in[12], DM, FF, WGUT, 1, 0, args.in[11], scr, r, lane); continue; } r -= I_F;
            if (r < I_F) { p0_transpose_item(args.in[13], DM, FF, WGUT, 1, 128, args.in[11], scr, r, lane); continue; } r -= I_F;
            p0_transpose_item(args.in[14], FF, DM, WDT, 0, 0, nullptr, scr, r, lane);
        }
        for (int it = vcu; it < 128; it += G) { const int g = it >> 5, cb = (it >> 1) & 15, n = (it & 1) * 512 + tid;
            const float* maps = args.in[4] + (size_t)(g * 128 + cb * 8) * 128; const float* sc = args.in[5] + g * 128; const float* wu = args.in[6] + (size_t)g * 128 * DM + n;
            float a[8];
#pragma unroll
            for (int ci = 0; ci < 8; ++ci) a[ci] = 0.f;
            for (int dd = 0; dd < 128; ++dd) { const float w = wu[(size_t)dd * DM] * sc[dd];
#pragma unroll
                for (int ci = 0; ci < 8; ++ci) a[ci] += maps[ci * 128 + dd] * w; }
            u32x4 o; o.x = pk2(a[0], a[1]); o.y = pk2(a[2], a[3]); o.z = pk2(a[4], a[5]); o.w = pk2(a[6], a[7]);
            *(u32x4*)(WPT + (size_t)n * 512 + g * 128 + cb * 8) = o; }
        for (int i = vcu * 512 + tid; i < SEQ * 8; i += G * 512) { const int pos = i >> 3, f = i & 7;
            const float invf = exp2f(-(float)f * (18.931568569324174f / 8.0f));
            const double rev = (double)pos * (double)invf * 0.15915494309189535; const float fr_ = (float)(rev - __builtin_rint(rev));
            const float sn = __builtin_amdgcn_sinf(fr_), cs = __builtin_amdgcn_cosf(fr_);
            ROPE[pos * 16 + f] = cs; ROPE[pos * 16 + 8 + f] = sn; }
        for (int m = gw; m < T; m += NGW) {
            const float* xrow = (m < 32 * SEQ) ? args.in[0] + (size_t)m * DM : args.in[1] + (size_t)(m - 32 * SEQ) * DM;
            const f32x4* xr = (const f32x4*)xrow + lane; f32x4 v[4]; float s = 0.f;
#pragma unroll
            for (int j = 0; j < 4; ++j) { v[j] = xr[64 * j]; s += (v[j].x * v[j].x + v[j].y * v[j].y) + (v[j].z * v[j].z + v[j].w * v[j].w); }
            const float rstd = 1.0f / sqrtf(wave_sum(s) * (1.0f / DM) + EPS);
            u32x2* o8 = (u32x2*)(XB + (size_t)m * DM) + lane;
#pragma unroll
            for (int j = 0; j < 4; ++j) { u32x2 w; w.x = pk2(v[j].x * rstd, v[j].y * rstd); w.y = pk2(v[j].z * rstd, v[j].w * rstd); o8[64 * j] = w; }
        }
        __syncthreads();
    }
    SEAM(0);
    if (IN(1)) {
        pg8::Gemm g{XB, W1T, T, N1, DM}; pg8::StaticOrder S; S.init(T, N1, G, bx);
        ep::EpiZG E{Z, GB, args.in[9], ROPE};
        pg8::gemm_phase<ep::EpiZG, pg8::StaticOrder, true, true>(lds, g, S, E);
    }
    SEAM(1);
    if (IN(2)) {
        for (int u = vcu; u < NB * 16; u += G) attn_unit(lds, Z, MERGED, u >> 4, (u >> 2) & 3, u & 3, wid, lane, tid);
        for (int u = vcu; u < NB * 32; u += G) pool_unit(lds, Z, POOLED, u >> 5, (u & 31) * 64, wid, lane, tid);
    }
    SEAM(2);
    if (IN(3)) {
        { pg8::Gemm g{POOLED, WPT, T, DM, 512}; pg8::StaticOrder S; S.init(T, DM, G, bx); ep::EpiGate<0> E{MB, GB};
          pg8::gemm_phase<ep::EpiGate<0>, pg8::StaticOrder, true, true>(lds, g, S, E); }
        { pg8::Gemm g{MERGED, WUAT, T, DM, 256}; pg8::StaticOrder S; S.init(T, DM, G, bx); ep::EpiGate<1> E{MB, GB};
          pg8::gemm_phase<ep::EpiGate<1>, pg8::StaticOrder, true, true>(lds, g, S, E); }
    }
    SEAM(3);
    if (IN(4)) {
        pg8::Gemm g{MB, WOT, T, DM, DM}; pg8::StaticOrder S; S.init(T, DM, G, bx);
        ep::EpiRes<1> E{args.in[0], args.in[1] - (size_t)32 * SEQ * DM, OUT, XB, SSQ2};
        pg8::gemm_phase<ep::EpiRes<1>, pg8::StaticOrder, true, true>(lds, g, S, E);
    }
    SEAM(4);
    if (IN(5)) {
        pg8::Gemm g{XB, WGUT, T, 2 * FF, DM}; pg8::StaticOrder S; S.init(T, 2 * FF, G, bx);
        ep::EpiSwiGLU E{ACT, SSQ2};
        pg8::gemm_phase<ep::EpiSwiGLU, pg8::StaticOrder, true, true>(lds, g, S, E);
    }
    SEAM(5);
    if (IN(6)) {
        pg8::Gemm g{ACT, WDT, T, DM, FF}; pg8::StaticOrder S; S.init(T, DM, G, bx);
        ep::EpiRes<0> E{OUT, OUT, OUT, nullptr, nullptr};
        pg8::gemm_phase<ep::EpiRes<0>, pg8::StaticOrder, true, true>(lds, g, S, E);
    }
    SEAM(6);
    if (IN(7)) {
        const int gw = vcu * NWAVES + wid, NGW = G * NWAVES;
        const f32x4* gp = (const f32x4*)args.in[15] + lane; f32x4 gn[4];
#pragma unroll
        for (int j = 0; j < 4; ++j) gn[j] = gp[64 * j];
        for (int m = gw; m < T; m += NGW) { f32x4* xr = (f32x4*)(OUT + (size_t)m * DM) + lane; f32x4 v[4]; float s = 0.f;
#pragma unroll
            for (int j = 0; j < 4; ++j) { v[j] = xr[64 * j]; s += (v[j].x * v[j].x + v[j].y * v[j].y) + (v[j].z * v[j].z + v[j].w * v[j].w); }
            const float rstd = 1.0f / sqrtf(wave_sum(s) * (1.0f / DM) + EPS);
#pragma unroll
            for (int j = 0; j < 4; ++j) xr[64 * j] = v[j] * rstd * gn[j]; }
    }
#undef IN
#undef SEAM
}

extern "C" void kernel_launch(void* const* d_in, const int* in_sizes, int n_in, void* d_out, int out_size, void* d_ws, size_t ws_size, hipStream_t stream) {
    static int grid = 0;
    if (grid == 0) {
        if (n_in != 16 || in_sizes[0] != 32 * SEQ * DM || in_sizes[1] != 16 * SEQ * DM || out_size != T * DM || ws_size < WS_END) {
            fprintf(stderr, "kernel_launch: unexpected shapes (n_in %d out %d ws %zu)\n", n_in, out_size, ws_size); grid = -1; return; }
        int dev = 0, cus = 0, per_cu = 0;
        hipGetDevice(&dev); hipDeviceGetAttribute(&cus, hipDeviceAttributeMultiprocessorCount, dev);
        hipFuncSetAttribute((const void*)mk_fwd, hipFuncAttributeMaxDynamicSharedMemorySize, LDS_BYTES);
        hipOccupancyMaxActiveBlocksPerMultiprocessor(&per_cu, (const void*)mk_fwd, NWAVES * 64, LDS_BYTES);
        (void)hipGetLastError();
        if (per_cu < 1) per_cu = 1;
        grid = cus * 1;
    }
    if (grid < 0) return;
    Args a{};
    for (int i = 0; i < 16; ++i) a.in[i] = (const float*)d_in[i];
    a.out = (float*)d_out; a.ws = (unsigned char*)d_ws;
#if MK_ONE_LAUNCH
    a.ph_lo = 0; a.ph_hi = 8;
    void* kargs[] = {&a};
    hipError_t e = hipLaunchCooperativeKernel((const void*)mk_fwd, dim3(grid), dim3(NWAVES * 64), kargs, LDS_BYTES, stream);
    if (e != hipSuccess) fprintf(stderr, "cooperative launch failed: %s (grid %d)\n", hipGetErrorString(e), grid);
#else
    for (int p = 0; p < 8; ++p) { a.ph_lo = p; a.ph_hi = p + 1; hipLaunchKernelGGL(mk_fwd, dim3(grid), dim3(NWAVES * 64), LDS_BYTES, stream, a); }
#endif
}
```

```cpp
#include <hip/hip_runtime.h>
#include <cstdio>
#include <cstdint>
namespace pg8 {
#define PG8_LAS __attribute__((address_space(3)))
typedef unsigned short bf16_t;
typedef short bf16x8 __attribute__((ext_vector_type(8)));
typedef float f32x4 __attribute__((ext_vector_type(4)));
typedef unsigned u32x4 __attribute__((ext_vector_type(4)));
constexpr int BM = 256, BK = 64, HALF = 128, HTB = HALF * BK * 2  , STAGE_BYTES = 8 * HTB, NXCD = 8, WGM = 8;

__host__ __device__ __forceinline__ int lds_byte(int r, int c) { const int st = (r >> 4) * 2 + (c >> 5), rr = r & 15, cc = c & 31, ob = rr * 64 + cc * 2; return st * 1024 + (ob ^ (((ob >> 9) & 1) << 5)); }
__host__ __device__ __forceinline__ void stage_rc(int b, int& R, int& C) { const int st = b / 1024, sb = b % 1024, swz = sb ^ (((sb >> 9) & 1) << 5); R = (st >> 1) * 16 + swz / 64; C = (st & 1) * 32 + (swz % 64) / 2; }
__host__ __device__ __forceinline__ int perm32(int rho) { const int n = rho >> 4, i = rho & 15; return 8 * (i >> 2) + 4 * n + (i & 3); }

struct Unit { int pm, pn; };
struct Gemm { const bf16_t* A; const bf16_t* Bt; int M, N, K; };

struct StaticOrder {
    int nM, nN, nwg, G, c;
    __host__ __device__ void init(int M, int N, int G_, int c_) { nM = M / BM; nN = N / BM; nwg = nM * nN; G = G_; c = c_; }
    __host__ __device__ bool next(int i, Unit& u) const {
        const long L = (long)i * G + c; if (L >= nwg) return false;
        int wgid = (int)L; { const int q = nwg / NXCD, r = nwg % NXCD, xcd = wgid % NXCD, off = wgid / NXCD; wgid = (xcd < r ? xcd * (q + 1) : r * (q + 1) + (xcd - r) * q) + off; }
        const int nig = WGM * nN, gid = wgid / nig, fm = gid * WGM, gsz = (nM - fm) < WGM ? (nM - fm) : WGM;
        u.pm = fm + ((wgid % nig) % gsz); u.pn = (wgid % nig) / gsz; return true;
    }
    __device__ __forceinline__ void a_ready(const Unit&) const {}
    __device__ __forceinline__ void done(const Unit&) const {}
};

__device__ __forceinline__ unsigned cvt_pk_bf16(float lo, float hi) { unsigned r; asm volatile("v_cvt_pk_bf16_f32 %0, %1, %2" : "=v"(r) : "v"(lo), "v"(hi)); return r; }
typedef float f32x2 __attribute__((ext_vector_type(2)));
__device__ __forceinline__ f32x2 gelu_pk(f32x2 v) {
    const f32x2 av = __builtin_elementwise_abs(v), d = av * 0.2316418882f + 1.0f;
    f32x2 t; t.x = __builtin_amdgcn_rcpf(d.x); t.y = __builtin_amdgcn_rcpf(d.y);
    f32x2 q = t * 0.5307027145f + (-0.7265760135f); q = q * t + 0.7107068705f; q = q * t + (-0.142248368f); q = q * t + 0.127414796f; q = q * t;
    const f32x2 s = (v * v) * (-0.72134752044f);
    f32x2 e; e.x = __builtin_amdgcn_exp2f(s.x); e.y = __builtin_amdgcn_exp2f(s.y);
    const f32x2 m = v * (q * e), r = v - m;
    f32x2 o; o.x = v.x < 0.f ? m.x : r.x; o.y = v.y < 0.f ? m.y : r.y; return o;
}

template <int ACT  > struct EpiBf16 {
    static constexpr bool PERM = true, AFTER_DRAIN = false; static_assert(ACT == 0 || ACT == 1, "EpiBf16: ACT is 0 (none) or 1 (gelu_pk)");
    bf16_t* O; int ldc; const float* bias; int split_cols; size_t split_stride; float scale0;
    __device__ __forceinline__ void operator()(const f32x4 (&acc)[2][2][4][2], const Unit& u, int wr, int wc, int fr, int fq) const {
        const int row0 = u.pm * BM + wr * 64 + fr; int colt = u.pn * BM; bf16_t* base = O;
        float sc = 1.f; if (split_cols) { const int t = colt / split_cols; base += (size_t)t * split_stride; colt -= t * split_cols; if (t == 0) sc = scale0; }
        const int col0 = colt + wc * 32 + 8 * fq, bcol0 = u.pn * BM + wc * 32 + 8 * fq;
        f32x4 bv[2][2];
#pragma unroll
        for (int bj = 0; bj < 2; ++bj)
#pragma unroll
            for (int n = 0; n < 2; ++n) bv[bj][n] = bias ? *(const f32x4*)(bias + bcol0 + bj * HALF + 4 * n) : (f32x4){0.f, 0.f, 0.f, 0.f};
#pragma unroll
        for (int ai = 0; ai < 2; ++ai)
#pragma unroll
            for (int m = 0; m < 4; ++m) { bf16_t* rowp = base + (size_t)(row0 + ai * HALF + m * 16) * ldc + col0;
#pragma unroll
                for (int bj = 0; bj < 2; ++bj) { f32x4 v0 = acc[ai][bj][m][0] + bv[bj][0], v1 = acc[ai][bj][m][1] + bv[bj][1];
                    if (ACT == 1) { f32x2 a = gelu_pk((f32x2){v0[0], v0[1]}), b = gelu_pk((f32x2){v0[2], v0[3]}), c = gelu_pk((f32x2){v1[0], v1[1]}), d = gelu_pk((f32x2){v1[2], v1[3]});
                        v0 = (f32x4){a.x, a.y, b.x, b.y}; v1 = (f32x4){c.x, c.y, d.x, d.y}; }
                    v0 = v0 * sc; v1 = v1 * sc; u32x4 w; w.x = cvt_pk_bf16(v0[0], v0[1]); w.y = cvt_pk_bf16(v0[2], v0[3]); w.z = cvt_pk_bf16(v1[0], v1[1]); w.w = cvt_pk_bf16(v1[2], v1[3]);
                    *(u32x4*)(rowp + bj * HALF) = w; } }
    }
};
template <class Epi, class Sched, bool ALIGN_EPI = false, bool SP2 = false>
__device__ __forceinline__ void gemm_phase(PG8_LAS unsigned char* lds, const Gemm g, const Sched& S, const Epi& E) {
    const int tid = threadIdx.x, wid = __builtin_amdgcn_readfirstlane(tid >> 6), lane = tid & 63, wr = wid >> 2, wc = wid & 3, fr = lane & 15, fq = lane >> 4;
    const int K = g.K, nt = K / BK;
    unsigned voffA[2], voffB[2];
#pragma unroll
    for (int i = 0; i < 2; ++i) { int R, C; stage_rc(tid * 16 + i * 8192, R, C); const int Rb = Epi::PERM ? ((R & ~31) + perm32(R & 31)) : R;
        voffA[i] = (unsigned)(R * K + C) * 2u; voffB[i] = (unsigned)(Rb * K + C) * 2u; }
    const size_t kstep = (size_t)(BK * 2);
    const size_t hstep = (size_t)HALF * K * 2;
    const size_t tstep = 2 * hstep;
    const unsigned ldsw = (unsigned)wid * 1024u;
    const int aoff = lds_byte(wr * 64 + fr, fq * 8), boff = lds_byte(wc * 32 + fr, fq * 8);
#define PG8_SA(b, h) (((b) * 2 + (h)) * HTB)
#define PG8_SB(b, h) ((4 + (b) * 2 + (h)) * HTB)
#define PG8_STAGE(bufoff, gbase, voff) do { _Pragma("unroll") for (int _i = 0; _i < 2; ++_i) \
        __builtin_amdgcn_global_load_lds((const unsigned*)((const char*)(gbase) + (voff)[_i]), (PG8_LAS unsigned*)(lds + (bufoff) + ldsw + _i * 8192), 16, 0, 0); } while (0)
#define PG8_LDA(dst, b, h) do { _Pragma("unroll") for (int m = 0; m < 4; ++m) _Pragma("unroll") for (int k = 0; k < 2; ++k) dst[m][k] = *(const PG8_LAS bf16x8*)(lds + PG8_SA(b, h) + aoff + m * 2048 + k * 1024); } while (0)
#define PG8_LDB(dst, b, h) do { _Pragma("unroll") for (int n = 0; n < 2; ++n) _Pragma("unroll") for (int k = 0; k < 2; ++k) dst[n][k] = *(const PG8_LAS bf16x8*)(lds + PG8_SB(b, h) + boff + n * 2048 + k * 1024); } while (0)
#define PG8_MMA(ai, bj, At, Bt) do { __builtin_amdgcn_s_setprio(1); _Pragma("unroll") for (int m = 0; m < 4; ++m) _Pragma("unroll") for (int n = 0; n < 2; ++n) _Pragma("unroll") for (int k = 0; k < 2; ++k) \
        acc[ai][bj][m][n] = __builtin_amdgcn_mfma_f32_16x16x32_bf16(Bt[n][k], At[m][k], acc[ai][bj][m][n], 0, 0, 0); __builtin_amdgcn_s_setprio(0); } while (0)
#define PG8_WAIT_V(n) asm volatile("s_waitcnt vmcnt(" #n ")" ::: "memory")
#define PG8_WAIT_L(n) asm volatile("s_waitcnt lgkmcnt(" #n ")" ::: "memory")
#define PG8_BAR __builtin_amdgcn_s_barrier()
#define PG8_SCHED __builtin_amdgcn_sched_barrier(0)
    Unit cur, nxt; int ui = 0;
    if (!S.next(0, cur)) return;
    f32x4 acc[2][2][4][2];
    if constexpr (Epi::INIT) E.init(acc, cur, wr, wc, fr, fq); else {
#pragma unroll
    for (int a = 0; a < 2; ++a)
#pragma unroll
        for (int b = 0; b < 2; ++b)
#pragma unroll
            for (int m = 0; m < 4; ++m)
#pragma unroll
                for (int n = 0; n < 2; ++n) acc[a][b][m][n] = (f32x4){0.f, 0.f, 0.f, 0.f};
    }
    bf16x8 At[4][2], B0[2][2], B1[2][2];
    const char* cA = (const char*)g.A + (size_t)cur.pm * tstep; const char* cB = (const char*)g.Bt + (size_t)cur.pn * tstep;
    S.a_ready(cur);
    if constexpr (SP2) {
        PG8_STAGE(PG8_SB(0, 0), cB, voffB); PG8_STAGE(PG8_SB(0, 1), cB + hstep, voffB); PG8_STAGE(PG8_SA(0, 0), cA, voffA); PG8_STAGE(PG8_SA(0, 1), cA + hstep, voffA);
        if (wr == 1) PG8_BAR;
        PG8_WAIT_V(2); PG8_BAR;
        PG8_STAGE(PG8_SB(1, 0), cB + kstep, voffB); PG8_STAGE(PG8_SA(1, 0), cA + kstep, voffA); PG8_STAGE(PG8_SB(1, 1), cB + hstep + kstep, voffB);
        PG8_WAIT_V(6); PG8_BAR;
    } else {
        PG8_STAGE(PG8_SB(0, 0), cB, voffB); PG8_STAGE(PG8_SA(0, 0), cA, voffA); PG8_STAGE(PG8_SB(0, 1), cB + hstep, voffB); PG8_STAGE(PG8_SA(0, 1), cA + hstep, voffA);
        if (wr == 1) PG8_BAR;
        PG8_WAIT_V(4); PG8_BAR;
        PG8_STAGE(PG8_SB(1, 0), cB + kstep, voffB); PG8_STAGE(PG8_SA(1, 0), cA + kstep, voffA); PG8_STAGE(PG8_SB(1, 1), cB + hstep + kstep, voffB);
        PG8_WAIT_V(6); PG8_BAR;
    }
    for (;;) {
        const bool has_next = S.next(ui + 1, nxt);
        const char* nA = has_next ? (const char*)g.A + (size_t)nxt.pm * tstep : cA; const char* nB = has_next ? (const char*)g.Bt + (size_t)nxt.pn * tstep : cB;
_Pragma("unroll 1")
        for (int t = 0; t < nt; t += 2) {
            const bool last = (t == nt - 2);
            const char* a1 = cA + (size_t)(t + 1) * kstep;
            const char* a2 = last ? nA : cA + (size_t)(t + 2) * kstep; const char* b2 = last ? nB : cB + (size_t)(t + 2) * kstep;
            const char* a3 = a2 + kstep; const char* b3 = b2 + kstep;
            if (last && has_next) S.a_ready(nxt);
            if constexpr (SP2) {
            PG8_LDB(B0, 0, 0); PG8_LDB(B1, 0, 1); PG8_SCHED; PG8_LDA(At, 0, 0); PG8_STAGE(PG8_SA(1, 1), a1 + hstep, voffA);
            PG8_WAIT_V(8); PG8_WAIT_L(0); PG8_BAR; PG8_MMA(0, 0, At, B0); PG8_MMA(0, 1, At, B1); PG8_BAR; PG8_SCHED;
            PG8_LDA(At, 0, 1); PG8_STAGE(PG8_SB(0, 0), b2, voffB); PG8_STAGE(PG8_SB(0, 1), b2 + hstep, voffB); PG8_STAGE(PG8_SA(0, 0), a2, voffA);
            PG8_WAIT_V(8); PG8_WAIT_L(0); PG8_BAR; PG8_MMA(1, 0, At, B0); PG8_MMA(1, 1, At, B1); PG8_BAR; PG8_SCHED;
            PG8_LDB(B0, 1, 0); PG8_LDB(B1, 1, 1); PG8_SCHED; PG8_LDA(At, 1, 0); PG8_STAGE(PG8_SA(0, 1), a2 + hstep, voffA);
            PG8_WAIT_V(8); PG8_WAIT_L(0); PG8_BAR; PG8_MMA(0, 0, At, B0); PG8_MMA(0, 1, At, B1); PG8_BAR; PG8_SCHED;
            PG8_LDA(At, 1, 1); PG8_STAGE(PG8_SB(1, 0), b3, voffB); PG8_STAGE(PG8_SB(1, 1), b3 + hstep, voffB); PG8_STAGE(PG8_SA(1, 0), a3, voffA);
            PG8_WAIT_V(8); PG8_WAIT_L(0); PG8_BAR; PG8_MMA(1, 0, At, B0); PG8_MMA(1, 1, At, B1); PG8_BAR; PG8_SCHED;
            } else {
            PG8_LDB(B0, 0, 0); PG8_SCHED; PG8_LDA(At, 0, 0); PG8_STAGE(PG8_SA(1, 1), a1 + hstep, voffA);
            PG8_WAIT_L(8); PG8_BAR; PG8_WAIT_L(0); PG8_MMA(0, 0, At, B0); PG8_BAR; PG8_SCHED;
            PG8_LDB(B1, 0, 1); PG8_STAGE(PG8_SB(0, 0), b2, voffB);
            PG8_BAR; PG8_WAIT_L(0); PG8_MMA(0, 1, At, B1); PG8_BAR;
            PG8_LDA(At, 0, 1); PG8_STAGE(PG8_SA(0, 0), a2, voffA);
            PG8_BAR; PG8_WAIT_L(0); PG8_MMA(1, 0, At, B0); PG8_BAR; PG8_SCHED;
            PG8_STAGE(PG8_SB(0, 1), b2 + hstep, voffB);
            PG8_WAIT_V(6); PG8_BAR; PG8_MMA(1, 1, At, B1); PG8_BAR;
            PG8_LDB(B0, 1, 0); PG8_SCHED; PG8_LDA(At, 1, 0); PG8_STAGE(PG8_SA(0, 1), a2 + hstep, voffA);
            PG8_WAIT_L(8); PG8_BAR; PG8_WAIT_L(0); PG8_MMA(0, 0, At, B0); PG8_BAR; PG8_SCHED;
            PG8_LDB(B1, 1, 1); PG8_STAGE(PG8_SB(1, 0), b3, voffB);
            PG8_BAR; PG8_WAIT_L(0); PG8_MMA(0, 1, At, B1); PG8_BAR;
            PG8_LDA(At, 1, 1); PG8_STAGE(PG8_SA(1, 0), a3, voffA);
            PG8_BAR; PG8_WAIT_L(0); PG8_MMA(1, 0, At, B0); PG8_BAR; PG8_SCHED;
            PG8_STAGE(PG8_SB(1, 1), b3 + hstep, voffB);
            PG8_WAIT_V(6); PG8_BAR; PG8_MMA(1, 1, At, B1); PG8_BAR;
            }
        }
        if constexpr (ALIGN_EPI) { if (wr == 0) PG8_BAR; }
        if constexpr (!Epi::AFTER_DRAIN) { E(acc, cur, wr, wc, fr, fq); S.done(cur); }
        if (!has_next) break;
        if constexpr (Epi::INIT) E.init(acc, nxt, wr, wc, fr, fq); else {
#pragma unroll
        for (int a = 0; a < 2; ++a)
#pragma unroll
            for (int b = 0; b < 2; ++b)
#pragma unroll
                for (int m = 0; m < 4; ++m)
#pragma unroll
                    for (int n = 0; n < 2; ++n) acc[a][b][m][n] = (f32x4){0.f, 0.f, 0.f, 0.f};
        }
        cur = nxt; cA = nA; cB = nB; ++ui;
        if constexpr (ALIGN_EPI) { if (wr == 1) PG8_BAR; }
    }
    PG8_WAIT_V(0);
    if constexpr (!ALIGN_EPI) { if (wr == 0) PG8_BAR; }
    PG8_BAR;
    if constexpr (Epi::AFTER_DRAIN) { E.fused(acc, cur, wr, wc, fr, fq, lds, wid, lane); S.done(cur); }
#undef PG8_SA
#undef PG8_SB
#undef PG8_STAGE
#undef PG8_LDA
#undef PG8_LDB
#undef PG8_MMA
#undef PG8_WAIT_V
#undef PG8_WAIT_L
#undef PG8_BAR
#undef PG8_SCHED
}
}

#include <hip/hip_cooperative_groups.h>
namespace cg = cooperative_groups;

#ifndef MK_ONE_LAUNCH
#define MK_ONE_LAUNCH 1
#endif

#define LAS __attribute__((address_space(3)))
typedef unsigned short bf16;
typedef float f32x4 __attribute__((ext_vector_type(4)));
typedef float f32x16 __attribute__((ext_vector_type(16)));
typedef unsigned u32x4 __attribute__((ext_vector_type(4)));
typedef unsigned u32x2 __attribute__((ext_vector_type(2)));
typedef short bf16x8 __attribute__((ext_vector_type(8)));
typedef short s16x4 __attribute__((ext_vector_type(4)));

constexpr int NWAVES = 8;
constexpr int SEQ = 2048, DM = 1024, NB = 48, T = NB * SEQ;
constexpr int ZW = 2816, GW = 2048, FF = 2816;
constexpr int N1 = ZW + GW;
constexpr float EPS = 1e-6f;
constexpr int LDS_BYTES = 147456, RING_BYTES = 131072;

constexpr size_t MiB = 1u << 20;
constexpr size_t WS_W1T = 1 * MiB, WS_WPT = 11 * MiB, WS_WUAT = 12 * MiB, WS_WOT = 13 * MiB, WS_WGUT = 15 * MiB, WS_WDT = 26 * MiB;
constexpr size_t WS_ROPE = 32 * MiB, WS_SSQ2 = 34 * MiB, WS_SLOTS = 40 * MiB, WS_CNT = 44 * MiB;
constexpr size_t WS_XB = 48 * MiB;
constexpr size_t WS_POOLED = WS_XB, WS_MERGED = WS_XB + 96 * MiB;
constexpr size_t WS_Z = 240 * MiB;
constexpr size_t WS_END = 768 * MiB;

__device__ __forceinline__ unsigned f2bf(float f) { unsigned u = __builtin_bit_cast(unsigned, f); return (u + 0x7fffu + ((u >> 16) & 1u)) >> 16; }
__device__ __forceinline__ unsigned pk2(float lo, float hi) { return f2bf(lo) | (f2bf(hi) << 16); }
__device__ __forceinline__ float bflo(unsigned w) { return __builtin_bit_cast(float, w << 16); }
__device__ __forceinline__ float bfhi(unsigned w) { return __builtin_bit_cast(float, w & 0xffff0000u); }
__device__ __forceinline__ float wave_sum(float v) {
#pragma unroll
    for (int o = 1; o < 64; o <<= 1) v += __shfl_xor(v, o);
    return v;
}
__device__ __forceinline__ float sigmoidf_(float x) { return 1.0f / (1.0f + __expf(-x)); }

namespace ep {
using pg8::Unit; using pg8::cvt_pk_bf16;
constexpr int BM = 256, HALF = 128;

__device__ __forceinline__ u32x4 pack8(const f32x4 v0, const f32x4 v1) {
    u32x4 w; w.x = cvt_pk_bf16(v0[0], v0[1]); w.y = cvt_pk_bf16(v0[2], v0[3]); w.z = cvt_pk_bf16(v1[0], v1[1]); w.w = cvt_pk_bf16(v1[2], v1[3]); return w;
}
__device__ __forceinline__ void unpack8(const u32x4 w, f32x4& v0, f32x4& v1) {
    v0 = (f32x4){bflo(w.x), bfhi(w.x), bflo(w.y), bfhi(w.y)}; v1 = (f32x4){bflo(w.z), bfhi(w.z), bflo(w.w), bfhi(w.w)};
}

struct EpiZG {
    static constexpr bool PERM = true, AFTER_DRAIN = false, INIT = false;
    bf16* Z; bf16* G; const float* bias; const float* rope;
    __device__ __forceinline__ void operator()(const f32x4 (&acc)[2][2][4][2], const Unit& u, int wr, int wc, int fr, int fq) const {
        const int row0 = u.pm * BM + wr * 64 + fr;
        const int cl = wc * 32 + 8 * fq;
        if (u.pn >= 11) {
            const int gc0 = (u.pn - 11) * BM + cl;
            f32x4 bv[2][2];
#pragma unroll
            for (int bj = 0; bj < 2; ++bj)
#pragma unroll
                for (int n = 0; n < 2; ++n) bv[bj][n] = *(const f32x4*)(bias + gc0 + bj * HALF + 4 * n);
#pragma unroll
            for (int ai = 0; ai < 2; ++ai)
#pragma unroll
                for (int m = 0; m < 4; ++m) { bf16* rowp = G + (size_t)(row0 + ai * HALF + m * 16) * GW + gc0;
#pragma unroll
                    for (int bj = 0; bj < 2; ++bj) { f32x4 v0 = acc[ai][bj][m][0] + bv[bj][0], v1 = acc[ai][bj][m][1] + bv[bj][1];
#pragma unroll
                        for (int j = 0; j < 4; ++j) { v0[j] = sigmoidf_(v0[j]); v1[j] = sigmoidf_(v1[j]); }
                        *(u32x4*)(rowp + bj * HALF) = pack8(v0, v1); }
                    asm volatile("" ::: "memory"); }
        } else {
            const int zc0 = u.pn * BM + cl;
            const bool rope_tile = (u.pn >= 2 && u.pn < 8);
            const float sc = (u.pn >= 2 && u.pn < 5) ? 0.125f : 1.0f;
            if (rope_tile && !(wc & 1)) {
                const float sgn = (fq == 0) ? -1.0f : 1.0f; const bool act = fq < 2;
#pragma unroll
                for (int am = 0; am < 4; ++am) { const int ai = am >> 1;
                    f32x4 tb[2][4];
#pragma unroll
                    for (int mm = 0; mm < 2; ++mm) { const int m = (am & 1) * 2 + mm; const int row = row0 + ai * HALF + m * 16; const f32x4* tp = (const f32x4*)(rope + (row & (SEQ - 1)) * 16);
#pragma unroll
                        for (int k = 0; k < 4; ++k) tb[mm][k] = tp[k]; }
#pragma unroll
                    for (int mm = 0; mm < 2; ++mm) { const int m = (am & 1) * 2 + mm; const int row = row0 + ai * HALF + m * 16;
                        const f32x4 c0 = tb[mm][0], c1 = tb[mm][1], s0 = tb[mm][2] * sgn, s1 = tb[mm][3] * sgn;
                        bf16* rowp = Z + (size_t)row * ZW + zc0;
#pragma unroll
                        for (int bj = 0; bj < 2; ++bj) { f32x4 v0 = acc[ai][bj][m][0], v1 = acc[ai][bj][m][1], p0, p1;
#pragma unroll
                            for (int j = 0; j < 4; ++j) { p0[j] = __shfl_xor(v0[j], 16); p1[j] = __shfl_xor(v1[j], 16); }
                            if (act) { v0 = v0 * c0 + p0 * s0; v1 = v1 * c1 + p1 * s1; }
                            v0 = v0 * sc; v1 = v1 * sc;
                            *(u32x4*)(rowp + bj * HALF) = pack8(v0, v1); } }
                    asm volatile("" ::: "memory"); }
            } else {
#pragma unroll
                for (int ai = 0; ai < 2; ++ai)
#pragma unroll
                    for (int m = 0; m < 4; ++m) { bf16* rowp = Z + (size_t)(row0 + ai * HALF + m * 16) * ZW + zc0;
#pragma unroll
                        for (int bj = 0; bj < 2; ++bj) *(u32x4*)(rowp + bj * HALF) = pack8(acc[ai][bj][m][0] * sc, acc[ai][bj][m][1] * sc); }
            }
        }
    }
};

template <int SECOND> struct EpiGate {
    static constexpr bool PERM = true, AFTER_DRAIN = false, INIT = false;
    bf16* MB; const bf16* G;
    __device__ __forceinline__ void operator()(const f32x4 (&acc)[2][2][4][2], const Unit& u, int wr, int wc, int fr, int fq) const {
        const int row0 = u.pm * BM + wr * 64 + fr, col0 = u.pn * BM + wc * 32 + 8 * fq;
#pragma unroll
        for (int am = 0; am < 4; ++am) { const int ai = am >> 1;
            u32x4 gw[2][2], tw[2][2];
#pragma unroll
            for (int mm = 0; mm < 2; ++mm) { const int m = (am & 1) * 2 + mm; const size_t row = (size_t)(row0 + ai * HALF + m * 16);
#pragma unroll
                for (int bj = 0; bj < 2; ++bj) { gw[mm][bj] = *(const u32x4*)(G + row * GW + SECOND * DM + col0 + bj * HALF); if (SECOND) tw[mm][bj] = *(const u32x4*)(MB + row * DM + col0 + bj * HALF); } }
#pragma unroll
            for (int mm = 0; mm < 2; ++mm) { const int m = (am & 1) * 2 + mm; const size_t row = (size_t)(row0 + ai * HALF + m * 16);
#pragma unroll
                for (int bj = 0; bj < 2; ++bj) { f32x4 g0, g1; unpack8(gw[mm][bj], g0, g1);
                    f32x4 v0 = acc[ai][bj][m][0] * g0, v1 = acc[ai][bj][m][1] * g1;
                    if (SECOND) { f32x4 t0, t1; unpack8(tw[mm][bj], t0, t1); v0 += t0; v1 += t1; }
                    *(u32x4*)(MB + row * DM + col0 + bj * HALF) = pack8(v0, v1); } }
            asm volatile("" ::: "memory"); }
    }
};

template <int FIRST> struct EpiRes {
    static constexpr bool PERM = true, AFTER_DRAIN = false, INIT = true;
    const float* base_lo; const float* base_hi; float* out; bf16* XB_; float* ssq; LAS float* red;
    __device__ __forceinline__ void init(f32x4 (&acc)[2][2][4][2], const Unit& u, int wr, int wc, int fr, int fq) const {
        const int row0 = u.pm * BM + wr * 64 + fr, col0 = u.pn * BM + wc * 32 + 8 * fq;
        const float* base = (u.pm < 256) ? base_lo : base_hi;
#pragma unroll
        for (int ai = 0; ai < 2; ++ai)
#pragma unroll
            for (int m = 0; m < 4; ++m)
#pragma unroll
                for (int bj = 0; bj < 2; ++bj) { const size_t off = (size_t)(row0 + ai * HALF + m * 16) * DM + col0 + bj * HALF;
                    acc[ai][bj][m][0] = *(const f32x4*)(base + off); acc[ai][bj][m][1] = *(const f32x4*)(base + off + 4); }
    }
    __device__ __forceinline__ void operator()(const f32x4 (&acc)[2][2][4][2], const Unit& u, int wr, int wc, int fr, int fq) const {
        const int row0 = u.pm * BM + wr * 64 + fr, col0 = u.pn * BM + wc * 32 + 8 * fq;
#pragma unroll
        for (int ai = 0; ai < 2; ++ai)
#pragma unroll
            for (int m = 0; m < 4; ++m) { const size_t row = (size_t)(row0 + ai * HALF + m * 16); float q = 0.f;
#pragma unroll
                for (int bj = 0; bj < 2; ++bj) { const size_t off = row * DM + col0 + bj * HALF;
                    const f32x4 v0 = acc[ai][bj][m][0], v1 = acc[ai][bj][m][1];
                    *(f32x4*)(out + off) = v0; *(f32x4*)(out + off + 4) = v1;
                    if (FIRST) { *(u32x4*)(XB_ + off) = pack8(v0, v1);
                        q += (v0[0] * v0[0] + v0[1] * v0[1]) + (v0[2] * v0[2] + v0[3] * v0[3]) + (v1[0] * v1[0] + v1[1] * v1[1]) + (v1[2] * v1[2] + v1[3] * v1[3]); } }
                if (FIRST) { q += __shfl_xor(q, 16); q += __shfl_xor(q, 32); if (fq == 0) red[wc * 256 + ai * HALF + wr * 64 + m * 16 + fr] = q; } }
        if (FIRST) {
            asm volatile("s_waitcnt lgkmcnt(0)" ::: "memory"); __builtin_amdgcn_s_barrier(); asm volatile("" ::: "memory");
            const int t = threadIdx.x;
            if (t < 256) ssq[(size_t)(u.pm * BM + t) * 4 + u.pn] = (red[t] + red[256 + t]) + (red[512 + t] + red[768 + t]);
        }
    }
};

struct EpiFinal {
    static constexpr bool PERM = true, AFTER_DRAIN = false, INIT = true;
    float* out; const float* gfin; unsigned* slots; unsigned* cnt; LAS float* red;
    __device__ __forceinline__ void init(f32x4 (&acc)[2][2][4][2], const Unit& u, int wr, int wc, int fr, int fq) const {
        const int row0 = u.pm * BM + wr * 64 + fr, col0 = u.pn * BM + wc * 32 + 8 * fq;
#pragma unroll
        for (int ai = 0; ai < 2; ++ai)
#pragma unroll
            for (int m = 0; m < 4; ++m)
#pragma unroll
                for (int bj = 0; bj < 2; ++bj) { const size_t off = (size_t)(row0 + ai * HALF + m * 16) * DM + col0 + bj * HALF;
                    acc[ai][bj][m][0] = *(const f32x4*)(out + off); acc[ai][bj][m][1] = *(const f32x4*)(out + off + 4); }
    }
    __device__ __forceinline__ void operator()(const f32x4 (&acc)[2][2][4][2], const Unit& u, int wr, int wc, int fr, int fq) const {
        const int row0 = u.pm * BM + wr * 64 + fr, col0 = u.pn * BM + wc * 32 + 8 * fq, t = threadIdx.x;
#pragma unroll
        for (int ai = 0; ai < 2; ++ai)
#pragma unroll
            for (int m = 0; m < 4; ++m) { float q = 0.f;
#pragma unroll
                for (int bj = 0; bj < 2; ++bj) { const f32x4 v0 = acc[ai][bj][m][0], v1 = acc[ai][bj][m][1];
                    q += (v0[0] * v0[0] + v0[1] * v0[1]) + (v0[2] * v0[2] + v0[3] * v0[3]) + (v1[0] * v1[0] + v1[1] * v1[1]) + (v1[2] * v1[2] + v1[3] * v1[3]); }
                q += __shfl_xor(q, 16); q += __shfl_xor(q, 32); if (fq == 0) red[wc * 256 + ai * HALF + wr * 64 + m * 16 + fr] = q; }
        asm volatile("s_waitcnt lgkmcnt(0)" ::: "memory"); __builtin_amdgcn_s_barrier(); asm volatile("" ::: "memory");
        if (t < 256) { const float s = (red[t] + red[256 + t]) + (red[512 + t] + red[768 + t]);
            __hip_atomic_store(slots + (size_t)(u.pm * BM + t) * 4 + u.pn, __builtin_bit_cast(unsigned, s), __ATOMIC_RELAXED, __HIP_MEMORY_SCOPE_AGENT); }
        asm volatile("s_waitcnt vmcnt(0)" ::: "memory");
        __builtin_amdgcn_s_barrier(); asm volatile("" ::: "memory");
        if (t == 0) { unsigned* c = cnt + 64 * u.pm;
            __hip_atomic_fetch_add(c, 1u, __ATOMIC_RELAXED, __HIP_MEMORY_SCOPE_AGENT);
            unsigned sp = 0;
            while (__hip_atomic_load(c, __ATOMIC_RELAXED, __HIP_MEMORY_SCOPE_AGENT) < 4u) { __builtin_amdgcn_s_sleep(1); if (++sp > (1u << 24)) break; }
            __builtin_amdgcn_fence(__ATOMIC_ACQUIRE, "agent"); }
        asm volatile("s_waitcnt vmcnt(0) lgkmcnt(0)" ::: "memory"); __builtin_amdgcn_s_barrier(); asm volatile("" ::: "memory");
        if (t < 256) { const unsigned* sl = slots + (size_t)(u.pm * BM + t) * 4; float s = 0.f;
#pragma unroll
            for (int k = 0; k < 4; ++k) s += __builtin_bit_cast(float, __hip_atomic_load(sl + k, __ATOMIC_RELAXED, __HIP_MEMORY_SCOPE_AGENT));
            red[1024 + t] = 1.0f / sqrtf(s * (1.0f / DM) + EPS); }
        asm volatile("s_waitcnt lgkmcnt(0)" ::: "memory"); __builtin_amdgcn_s_barrier(); asm volatile("" ::: "memory");
        f32x4 gv[2][2];
#pragma unroll
        for (int bj = 0; bj < 2; ++bj)
#pragma unroll
            for (int n = 0; n < 2; ++n) gv[bj][n] = *(const f32x4*)(gfin + col0 + bj * HALF + 4 * n);
#pragma unroll
        for (int ai = 0; ai < 2; ++ai)
#pragma unroll
            for (int m = 0; m < 4; ++m) { const int rl = ai * HALF + wr * 64 + m * 16 + fr; const float r = red[1024 + rl];
#pragma unroll
                for (int bj = 0; bj < 2; ++bj) { const size_t off = (size_t)(u.pm * BM + rl) * DM + col0 + bj * HALF;
                    *(f32x4*)(out + off) = acc[ai][bj][m][0] * r * gv[bj][0]; *(f32x4*)(out + off + 4) = acc[ai][bj][m][1] * r * gv[bj][1]; } }
    }
};

struct EpiSwiGLU {
    static constexpr bool PERM = true, AFTER_DRAIN = false, INIT = false;
    bf16* ACT; const float* ssq;
    __device__ __forceinline__ void operator()(const f32x4 (&acc)[2][2][4][2], const Unit& u, int wr, int wc, int fr, int fq) const {
        const int row0 = u.pm * BM + wr * 64 + fr, col0 = u.pn * HALF + wc * 32 + 8 * fq;
        f32x4 sv[2][4];
#pragma unroll
        for (int ai = 0; ai < 2; ++ai)
#pragma unroll
            for (int m = 0; m < 4; ++m) sv[ai][m] = *(const f32x4*)(ssq + (size_t)(row0 + ai * HALF + m * 16) * 4);
#pragma unroll
        for (int ai = 0; ai < 2; ++ai)
#pragma unroll
            for (int m = 0; m < 4; ++m) { const size_t row = (size_t)(row0 + ai * HALF + m * 16); const f32x4 s4 = sv[ai][m];
                const float rstd = 1.0f / sqrtf(((s4[0] + s4[1]) + (s4[2] + s4[3])) * (1.0f / DM) + EPS);
                f32x4 g0 = acc[ai][0][m][0] * rstd, g1 = acc[ai][0][m][1] * rstd, u0 = acc[ai][1][m][0] * rstd, u1 = acc[ai][1][m][1] * rstd;
#pragma unroll
                for (int j = 0; j < 4; ++j) { g0[j] = g0[j] * sigmoidf_(g0[j]) * u0[j]; g1[j] = g1[j] * sigmoidf_(g1[j]) * u1[j]; }
                *(u32x4*)(ACT + row * FF + col0) = pack8(g0, g1); }
    }
};
}

__device__ __forceinline__ void p0_transpose_item(const float* W, int K, int N, bf16* WT, int mode, int row_off, const float* gain, LAS float* scr, int item, int lane) {
    const int nblk = N / 32, kb = item / nblk, nb = item % nblk, k0 = 64 * kb, n0 = 32 * nb;
    { f32x4 wv[8]; float gv[8];
#pragma unroll
      for (int i = 0; i < 8; ++i) { const int kk = (lane >> 3) + 8 * i; wv[i] = *(const f32x4*)(W + (size_t)(k0 + kk) * N + n0 + (lane & 7) * 4); gv[i] = gain ? gain[k0 + kk] : 1.0f; }
#pragma unroll
      for (int i = 0; i < 8; ++i) { const int kk = (lane >> 3) + 8 * i; LAS float* d = scr + kk * 33 + (lane & 7) * 4; d[0] = wv[i].x * gv[i]; d[1] = wv[i].y * gv[i]; d[2] = wv[i].z * gv[i]; d[3] = wv[i].w * gv[i]; } }
    asm volatile("s_waitcnt lgkmcnt(0)" ::: "memory");
    const int c = lane & 7;
#pragma unroll
    for (int j = 0; j < 4; ++j) { const int n = (lane >> 3) + 8 * j; const LAS float* s = scr + (8 * c) * 33 + n;
        u32x4 o; o.x = pk2(s[0 * 33], s[1 * 33]); o.y = pk2(s[2 * 33], s[3 * 33]); o.z = pk2(s[4 * 33], s[5 * 33]); o.w = pk2(s[6 * 33], s[7 * 33]);
        const int col = n0 + n; const int orow = (mode ? (((col >> 7) << 8) + (col & 127)) : col) + row_off;
        *(u32x4*)(WT + (size_t)orow * K + k0 + 8 * c) = o; }
    asm volatile("s_waitcnt lgkmcnt(0)" ::: "memory");
}

#define MFMA32(a, b, c) __builtin_amdgcn_mfma_f32_32x32x16_bf16((a), (b), (c), 0, 0, 0)
__device__ __forceinline__ int crow(int reg, int h) { return (reg & 3) + 8 * (reg >> 2) + 4 * h; }
__device__ __forceinline__ bf16x8 pack_step(const f32x16& x, int s) {
    u32x4 p;
    asm volatile("v_cvt_pk_bf16_f32 %0, %4, %5\n\tv_cvt_pk_bf16_f32 %1, %6, %7\n\tv_cvt_pk_bf16_f32 %2, %8, %9\n\tv_cvt_pk_bf16_f32 %3, %10, %11\n\ts_nop 1"
                 : "=&v"(p[0]), "=&v"(p[1]), "=&v"(p[2]), "=&v"(p[3])
                 : "v"(x[8 * s]), "v"(x[8 * s + 1]), "v"(x[8 * s + 2]), "v"(x[8 * s + 3]), "v"(x[8 * s + 4]), "v"(x[8 * s + 5]), "v"(x[8 * s + 6]), "v"(x[8 * s + 7]));
    return __builtin_bit_cast(bf16x8, p);
}
__device__ __forceinline__ void tr_read4(unsigned a, s16x4& lo0, s16x4& hi0, s16x4& lo1, s16x4& hi1) {
    asm volatile("ds_read_b64_tr_b16 %0, %4\n\tds_read_b64_tr_b16 %1, %4 offset:1152\n\tds_read_b64_tr_b16 %2, %4 offset:64\n\tds_read_b64_tr_b16 %3, %4 offset:1216\n\ts_waitcnt lgkmcnt(0)"
                 : "=&v"(lo0), "=&v"(hi0), "=&v"(lo1), "=&v"(hi1) : "v"(a) : "memory");
}
constexpr int AT_OPITCH = 144, AT_LSE_OFF = 512 * AT_OPITCH, AT_VST_OFF = AT_LSE_OFF + 2048, AT_VPITCH = 144, AT_VST_BYTES = 32 * AT_VPITCH;
static_assert(AT_VST_OFF + NWAVES * AT_VST_BYTES <= RING_BYTES, "attention LDS");
static_assert(8 * AT_VPITCH == 1152, "tr_read4 offsets");

__device__ __forceinline__ void attn_unit(LAS unsigned char* lds, const bf16* Z, bf16* MERGED, int b, int hq, int chunk, int wid, int lane, int tid) {
    const int r32 = lane & 31, h = lane >> 5;
    const bf16* zb = Z + (size_t)b * SEQ * ZW;
    LAS unsigned char* vst = lds + AT_VST_OFF + wid * AT_VST_BYTES;
    LAS float* LSE = (LAS float*)(lds + AT_LSE_OFF);
    const float NEG = -INFINITY;
#pragma unroll 1
    for (int g = 0; g < 3; ++g) {
        const int sh = 2 * g, d = 1 << sh, bpr = 16 >> sh, n = SEQ >> sh, hg = 4 * g + hq;
#pragma unroll 1
        for (int wbi = 0; wbi < 2; ++wbi) {
            const int wb = wid * 2 + wbi, r = wb / bpr, q0 = chunk * (512 >> sh) + 32 * (wb % bpr);
            const int qtok = (q0 + r32) * d + r;
            bf16x8 qf[4], kf[5][4];
            { const u32x4* qp = (const u32x4*)(zb + (size_t)qtok * ZW + 512 + hg * 64 + 8 * h);
#pragma unroll
              for (int s = 0; s < 4; ++s) qf[s] = __builtin_bit_cast(bf16x8, qp[2 * s]); }
#pragma unroll
            for (int c = 0; c < 5; ++c) { int j = q0 - 64 + 32 * c + r32; j = j < 0 ? 0 : (j >= n ? n - 1 : j);
                const u32x4* kp = (const u32x4*)(zb + (size_t)(j * d + r) * ZW + 1280 + hg * 64 + 8 * h);
#pragma unroll
                for (int s = 0; s < 4; ++s) kf[c][s] = __builtin_bit_cast(bf16x8, kp[2 * s]); }
            f32x16 S[5];
#pragma unroll
            for (int c = 0; c < 5; ++c) {
                const int j0 = q0 - 64 + 32 * c; const bool tv = (j0 >= 0 && j0 < n);
                f32x16 a;
#pragma unroll
                for (int i = 0; i < 16; ++i) a[i] = 0.f;
#pragma unroll
                for (int s = 0; s < 4; ++s) a = MFMA32(kf[c][s], qf[s], a);
#pragma unroll
                for (int i = 0; i < 16; ++i) { bool ok = tv; if (c == 0) ok = ok && (crow(i, h) >= r32); if (c == 4) ok = ok && (crow(i, h) <= r32); a[i] = ok ? a[i] : NEG; }
                S[c] = a;
            }
            u32x4 v4[5][4];
#pragma unroll
            for (int c = 0; c < 5; ++c) { int j = q0 - 64 + 32 * c + (lane >> 1); j = j < 0 ? 0 : (j >= n ? n - 1 : j);
                const u32x4* vp = (const u32x4*)(zb + (size_t)(j * d + r) * ZW + 2048 + hg * 64 + (lane & 1) * 32);
#pragma unroll
                for (int i = 0; i < 4; ++i) v4[c][i] = vp[i]; }
            float mx = NEG;
#pragma unroll
            for (int c = 0; c < 5; ++c)
#pragma unroll
                for (int i = 0; i < 16; ++i) mx = fmaxf(mx, S[c][i]);
            mx = fmaxf(mx, __shfl_xor(mx, 32));
            float den = 0.f;
#pragma unroll
            for (int c = 0; c < 5; ++c)
#pragma unroll
                for (int i = 0; i < 16; ++i) { const float p = __expf(S[c][i] - mx); S[c][i] = p; den += p; }
            den += __shfl_xor(den, 32);
            f32x16 O0, O1;
#pragma unroll
            for (int i = 0; i < 16; ++i) { O0[i] = 0.f; O1[i] = 0.f; }
            const unsigned trbase = (unsigned)(size_t)vst + (4 * h + ((lane & 15) >> 2)) * AT_VPITCH + 32 * ((lane >> 4) & 1) + 8 * (lane & 3);
#pragma unroll
            for (int c = 0; c < 5; ++c) {
                LAS u32x4* vw = (LAS u32x4*)(vst + (lane >> 1) * AT_VPITCH + (lane & 1) * 64);
#pragma unroll
                for (int i = 0; i < 4; ++i) vw[i] = v4[c][i];
                asm volatile("s_waitcnt lgkmcnt(0)" ::: "memory");
#pragma unroll
                for (int s = 0; s < 2; ++s) {
                    const bf16x8 pf = pack_step(S[c], s);
                    s16x4 lo0, hi0, lo1, hi1;
                    tr_read4(trbase + 16 * s * AT_VPITCH, lo0, hi0, lo1, hi1);
                    const bf16x8 va0 = __builtin_shufflevector(lo0, hi0, 0, 1, 2, 3, 4, 5, 6, 7), va1 = __builtin_shufflevector(lo1, hi1, 0, 1, 2, 3, 4, 5, 6, 7);
                    O0 = MFMA32(va0, pf, O0); O1 = MFMA32(va1, pf, O1);
                }
            }
            const float inv = 1.0f / den, lse = mx + __logf(den);
            const int tokidx = qtok - chunk * 512;
            LAS unsigned char* orow = lds + tokidx * AT_OPITCH + 8 * h;
            float wo = 0.f, wn = inv, lnew = lse;
            if (g > 0) { const float lold = LSE[tokidx]; const float mxl = fmaxf(lold, lse); lnew = mxl + __logf(__expf(lold - mxl) + __expf(lse - mxl)); wo = __expf(lold - lnew); wn = __expf(lse - lnew) * inv; }
#pragma unroll
            for (int dt = 0; dt < 2; ++dt)
#pragma unroll
                for (int a4 = 0; a4 < 4; ++a4) {
                    LAS u32x2* p = (LAS u32x2*)(orow + dt * 64 + a4 * 16);
                    f32x4 v;
#pragma unroll
                    for (int j = 0; j < 4; ++j) v[j] = (dt ? O1[4 * a4 + j] : O0[4 * a4 + j]) * wn;
                    if (g > 0) { const u32x2 ow = *p; v[0] += wo * bflo(ow.x); v[1] += wo * bfhi(ow.x); v[2] += wo * bflo(ow.y); v[3] += wo * bfhi(ow.y); }
                    u32x2 nw; nw.x = pk2(v[0], v[1]); nw.y = pk2(v[2], v[3]); *p = nw;
                }
            if (h == 0) LSE[tokidx] = lnew;
        }
        __syncthreads();
    }
    bf16* mo = MERGED + ((size_t)b * SEQ + chunk * 512) * 256 + hq * 64;
#pragma unroll
    for (int it = 0; it < 8; ++it) { const int idx = tid + 512 * it, tok = idx >> 3, pc = idx & 7;
        const u32x4 w = *(const LAS u32x4*)(lds + tok * AT_OPITCH + pc * 16);
        *(u32x4*)(mo + (size_t)tok * 256 + pc * 8) = w; }
    __syncthreads();
}

__device__ __forceinline__ void pool_unit(LAS unsigned char* lds, const bf16* Z, bf16* POOLED, int b, int t0, int wid, int lane, int tid) {
    const bf16* zb = Z + (size_t)b * SEQ * ZW;
    { u32x4 rv[10];
#pragma unroll
      for (int k = 0; k < 10; ++k) { int t = t0 - 8 + wid + 8 * k; t = t < 0 ? 0 : (t >= SEQ ? SEQ - 1 : t); rv[k] = *(const u32x4*)(zb + (size_t)t * ZW + lane * 8); }
#pragma unroll
      for (int k = 0; k < 10; ++k) *(LAS u32x4*)(lds + (wid + 8 * k) * 1024 + lane * 16) = rv[k]; }
    __syncthreads();
#pragma unroll 1
    for (int k = 0; k < 8; ++k) { const int idx = tid + 512 * k, tl = idx >> 6, cu = idx & 63, t = t0 + tl, hw = 1 << (cu >> 4);
        const int lo = (t - hw) < 0 ? 0 : (t - hw), hi = (t + hw) > SEQ ? SEQ : (t + hw);
        f32x4 s0 = (f32x4){0.f, 0.f, 0.f, 0.f}, s1 = s0;
        for (int j = lo; j < hi; ++j) { const u32x4 w = *(const LAS u32x4*)(lds + (j - t0 + 8) * 1024 + cu * 16); f32x4 a0, a1; ep::unpack8(w, a0, a1); s0 += a0; s1 += a1; }
        const float ic = 1.0f / (float)(hi - lo);
        const u32x4 w = *(const LAS u32x4*)(lds + (tl + 8) * 1024 + cu * 16); f32x4 a0, a1; ep::unpack8(w, a0, a1);
        s0 = s0 * ic - a0; s1 = s1 * ic - a1;
        u32x4 o; o.x = pk2(s0[0], s0[1]); o.y = pk2(s0[2], s0[3]); o.z = pk2(s1[0], s1[1]); o.w = pk2(s1[2], s1[3]);
        *(u32x4*)(POOLED + ((size_t)b * SEQ + t) * 512 + cu * 8) = o; }
    __syncthreads();
}

struct Args { const float* in[16]; float* out; unsigned char* ws; int ph_lo, ph_hi; };

__global__ void __launch_bounds__(NWAVES * 64, 2) mk_fwd(Args args) {
    extern __shared__ __attribute__((aligned(16))) unsigned char lds_raw[];
    LAS unsigned char* lds = (LAS unsigned char*)lds_raw;
    cg::grid_group grid = cg::this_grid();
    const int tid = threadIdx.x, lane = tid & 63, wid = __builtin_amdgcn_readfirstlane(tid >> 6);
    const int G = gridDim.x, bx = blockIdx.x;
    const int vcu = (G % 8 == 0) ? (bx % 8) * (G / 8) + bx / 8 : bx;
    const __attribute__((address_space(4))) unsigned char* ka = (const __attribute__((address_space(4))) unsigned char*)__builtin_amdgcn_kernarg_segment_ptr();
    typedef const float* cfp_t; typedef unsigned char* ucp_t;
#define ARG_IN(i) (*(volatile cfp_t __attribute__((address_space(4)))*)(ka + 8 * (i)))
#define ARG_OUT() ((float*)*(volatile cfp_t __attribute__((address_space(4)))*)(ka + 128))
#define ARG_WS() (*(volatile ucp_t __attribute__((address_space(4)))*)(ka + 136))
#define WSP(off) ((bf16*)(ws + (off)))
    const int lo = args.ph_lo, hi = args.ph_hi;
#ifndef PH_MASK
#define PH_MASK 255
#endif
#define IN(k) (((PH_MASK >> (k)) & 1) && lo <= (k) && (k) < hi)
#define SEAM(k) do { if (IN(k) && IN((k) + 1)) grid.sync(); } while (0)
#ifndef PROBE_DUP
#define PROBE_DUP -1
#endif
#define REPS(k) for (int rep_ = 0; rep_ < ((PROBE_DUP == (k)) ? 2 : 1); ++rep_)

    REPS(0) if (IN(0)) { if (rep_) grid.sync();
        unsigned char* ws = ARG_WS();
        bf16* W1T = WSP(WS_W1T); bf16* WPT = WSP(WS_WPT); bf16* WUAT = WSP(WS_WUAT); bf16* WOT = WSP(WS_WOT); bf16* WGUT = WSP(WS_WGUT); bf16* WDT = WSP(WS_WDT);
        float* ROPE = (float*)(ws + WS_ROPE); bf16* XB = WSP(WS_XB);
        LAS float* scr = (LAS float*)(lds + wid * 16384);
        const int gw = vcu * NWAVES + wid, NGW = G * NWAVES;
        constexpr int I_IN = (DM / 64) * (ZW / 32), I_G = (DM / 64) * (GW / 32), I_UA = (256 / 64) * (DM / 32), I_O = (DM / 64) * (DM / 32), I_F = (DM / 64) * (FF / 32), I_D = (FF / 64) * (DM / 32);
        constexpr int NITEMS = I_IN + I_G + I_UA + I_O + 2 * I_F + I_D;
        for (int it = gw; it < NITEMS; it += NGW) {
            int r = it;
            if (r < I_IN) { p0_transpose_item(ARG_IN(3), DM, ZW, W1T, 0, 0, ARG_IN(2), scr, r, lane); continue; } r -= I_IN;
            if (r < I_G) { p0_transpose_item(ARG_IN(8), DM, GW, W1T, 0, ZW, ARG_IN(2), scr, r, lane); continue; } r -= I_G;
            if (r < I_UA) { p0_transpose_item(ARG_IN(7), 256, DM, WUAT, 0, 0, nullptr, scr, r, lane); continue; } r -= I_UA;
            if (r < I_O) { p0_transpose_item(ARG_IN(10), DM, DM, WOT, 0, 0, nullptr, scr, r, lane); continue; } r -= I_O;
            if (r < I_F) { p0_transpose_item(ARG_IN(12), DM, FF, WGUT, 1, 0, ARG_IN(11), scr, r, lane); continue; } r -= I_F;
            if (r < I_F) { p0_transpose_item(ARG_IN(13), DM, FF, WGUT, 1, 128, ARG_IN(11), scr, r, lane); continue; } r -= I_F;
            p0_transpose_item(ARG_IN(14), FF, DM, WDT, 0, 0, nullptr, scr, r, lane);
        }
        for (int it = vcu; it < 128; it += G) { const int g = it >> 5, cb = (it >> 1) & 15, n = (it & 1) * 512 + tid;
            const float* maps = ARG_IN(4) + (size_t)(g * 128 + cb * 8) * 128; const float* sc = ARG_IN(5) + g * 128; const float* wu = ARG_IN(6) + (size_t)g * 128 * DM + n;
            float a[8];
#pragma unroll
            for (int ci = 0; ci < 8; ++ci) a[ci] = 0.f;
            for (int dd = 0; dd < 128; ++dd) { const float w = wu[(size_t)dd * DM] * sc[dd];
#pragma unroll
                for (int ci = 0; ci < 8; ++ci) a[ci] += maps[ci * 128 + dd] * w; }
            u32x4 o; o.x = pk2(a[0], a[1]); o.y = pk2(a[2], a[3]); o.z = pk2(a[4], a[5]); o.w = pk2(a[6], a[7]);
            *(u32x4*)(WPT + (size_t)n * 512 + g * 128 + cb * 8) = o; }
        for (int i = vcu * 512 + tid; i < 384 * 64; i += G * 512) ((unsigned*)(ws + WS_CNT))[i] = 0u;
        for (int i = vcu * 512 + tid; i < SEQ * 8; i += G * 512) { const int pos = i >> 3, f = i & 7;
            const float invf = exp2f(-(float)f * (18.931568569324174f / 8.0f));
            const double rev = (double)pos * (double)invf * 0.15915494309189535; const float fr_ = (float)(rev - __builtin_rint(rev));
            const float sn = __builtin_amdgcn_sinf(fr_), cs = __builtin_amdgcn_cosf(fr_);
            ROPE[pos * 16 + f] = cs; ROPE[pos * 16 + 8 + f] = sn; }
        for (int m0 = gw * 4; m0 < T; m0 += NGW * 4) {
            f32x4 v[4][4];
#pragma unroll
            for (int rr = 0; rr < 4; ++rr) { const int m = m0 + rr;
                const float* xrow = (m < 32 * SEQ) ? ARG_IN(0) + (size_t)m * DM : ARG_IN(1) + (size_t)(m - 32 * SEQ) * DM;
                const f32x4* xr = (const f32x4*)xrow + lane;
#pragma unroll
                for (int j = 0; j < 4; ++j) v[rr][j] = xr[64 * j]; }
#pragma unroll
            for (int rr = 0; rr < 4; ++rr) { float s = 0.f;
#pragma unroll
                for (int j = 0; j < 4; ++j) s += (v[rr][j].x * v[rr][j].x + v[rr][j].y * v[rr][j].y) + (v[rr][j].z * v[rr][j].z + v[rr][j].w * v[rr][j].w);
                const float rstd = 1.0f / sqrtf(wave_sum(s) * (1.0f / DM) + EPS);
                u32x2* o8 = (u32x2*)(XB + (size_t)(m0 + rr) * DM) + lane;
#pragma unroll
                for (int j = 0; j < 4; ++j) { u32x2 w; w.x = pk2(v[rr][j].x * rstd, v[rr][j].y * rstd); w.y = pk2(v[rr][j].z * rstd, v[rr][j].w * rstd); o8[64 * j] = w; } }
        }
        __syncthreads();
    }
    SEAM(0);
    REPS(1) if (IN(1)) { if (rep_) grid.sync();
        unsigned char* ws = ARG_WS();
        pg8::Gemm g{WSP(WS_XB), WSP(WS_W1T), T, N1, DM}; pg8::StaticOrder S; S.init(T, N1, G, bx);
        ep::EpiZG E{WSP(WS_Z), (bf16*)ARG_OUT(), ARG_IN(9), (const float*)(ws + WS_ROPE)};
        pg8::gemm_phase<ep::EpiZG, pg8::StaticOrder, true, true>(lds, g, S, E);
    }
    SEAM(1);
    REPS(2) if (IN(2)) { if (rep_) grid.sync();
        unsigned char* ws = ARG_WS(); const bf16* Z = WSP(WS_Z); bf16* MERGED = WSP(WS_MERGED); bf16* POOLED = WSP(WS_POOLED);
        for (int u = vcu; u < NB * 16; u += G) attn_unit(lds, Z, MERGED, u >> 4, (u >> 2) & 3, u & 3, wid, lane, tid);
        for (int u = vcu; u < NB * 32; u += G) pool_unit(lds, Z, POOLED, u >> 5, (u & 31) * 64, wid, lane, tid);
    }
    SEAM(2);
    REPS(3) if (IN(3)) { if (rep_) grid.sync();
        unsigned char* ws = ARG_WS(); bf16* MB = WSP(WS_Z); const bf16* GB = (const bf16*)ARG_OUT();
        { pg8::Gemm g{WSP(WS_POOLED), WSP(WS_WPT), T, DM, 512}; pg8::StaticOrder S; S.init(T, DM, G, bx); ep::EpiGate<0> E{MB, GB};
          pg8::gemm_phase<ep::EpiGate<0>, pg8::StaticOrder, true, true>(lds, g, S, E); }
        { pg8::Gemm g{WSP(WS_MERGED), WSP(WS_WUAT), T, DM, 256}; pg8::StaticOrder S; S.init(T, DM, G, bx); ep::EpiGate<1> E{MB, GB};
          pg8::gemm_phase<ep::EpiGate<1>, pg8::StaticOrder, true, true>(lds, g, S, E); }
    }
    SEAM(3);
    REPS(4) if (IN(4)) { if (rep_) grid.sync();
        unsigned char* ws = ARG_WS();
        pg8::Gemm g{WSP(WS_Z), WSP(WS_WOT), T, DM, DM}; pg8::StaticOrder S; S.init(T, DM, G, bx);
        ep::EpiRes<1> E{ARG_IN(0), ARG_IN(1) - (size_t)32 * SEQ * DM, ARG_OUT(), WSP(WS_XB), (float*)(ws + WS_SSQ2), (LAS float*)(lds + RING_BYTES)};
        pg8::gemm_phase<ep::EpiRes<1>, pg8::StaticOrder, true, true>(lds, g, S, E);
    }
    SEAM(4);
    REPS(5) if (IN(5)) { if (rep_) grid.sync();
        unsigned char* ws = ARG_WS();
        pg8::Gemm g{WSP(WS_XB), WSP(WS_WGUT), T, 2 * FF, DM}; pg8::StaticOrder S; S.init(T, 2 * FF, G, bx);
        ep::EpiSwiGLU E{WSP(WS_Z), (const float*)(ws + WS_SSQ2)};
        pg8::gemm_phase<ep::EpiSwiGLU, pg8::StaticOrder, true, true>(lds, g, S, E);
    }
    SEAM(5);
    if (IN(6)) {
        unsigned char* ws = ARG_WS();
        pg8::Gemm g{WSP(WS_Z), WSP(WS_WDT), T, DM, FF}; pg8::StaticOrder S; S.init(T, DM, G, bx);
        ep::EpiFinal E{ARG_OUT(), ARG_IN(15), (unsigned*)(ws + WS_SLOTS), (unsigned*)(ws + WS_CNT), (LAS float*)(lds + RING_BYTES)};
        pg8::gemm_phase<ep::EpiFinal, pg8::StaticOrder, true, true>(lds, g, S, E);
    }
#undef IN
#undef SEAM
}

extern "C" void kernel_launch(void* const* d_in, const int* in_sizes, int n_in, void* d_out, int out_size, void* d_ws, size_t ws_size, hipStream_t stream) {
    static int grid = 0;
    if (grid == 0) {
        if (n_in != 16 || in_sizes[0] != 32 * SEQ * DM || in_sizes[1] != 16 * SEQ * DM || out_size != T * DM || ws_size < WS_END) {
            fprintf(stderr, "kernel_launch: unexpected shapes (n_in %d out %d ws %zu)\n", n_in, out_size, ws_size); grid = -1; return; }
        int dev = 0, cus = 0, per_cu = 0;
        hipGetDevice(&dev); hipDeviceGetAttribute(&cus, hipDeviceAttributeMultiprocessorCount, dev);
        hipFuncSetAttribute((const void*)mk_fwd, hipFuncAttributeMaxDynamicSharedMemorySize, LDS_BYTES);
        hipOccupancyMaxActiveBlocksPerMultiprocessor(&per_cu, (const void*)mk_fwd, NWAVES * 64, LDS_BYTES);
        (void)hipGetLastError();
        if (per_cu < 1) per_cu = 1;
        grid = cus * 1;
    }
    if (grid < 0) return;
    Args a{};
    for (int i = 0; i < 16; ++i) a.in[i] = (const float*)d_in[i];
    a.out = (float*)d_out; a.ws = (unsigned char*)d_ws;
#if MK_ONE_LAUNCH
    a.ph_lo = 0; a.ph_hi = 7;
    void* kargs[] = {&a};
    hipError_t e = hipLaunchCooperativeKernel((const void*)mk_fwd, dim3(grid), dim3(NWAVES * 64), kargs, LDS_BYTES, stream);
    if (e != hipSuccess) fprintf(stderr, "cooperative launch failed: %s (grid %d)\n", hipGetErrorString(e), grid);
#else
    for (int p = 0; p < 7; ++p) { a.ph_lo = p; a.ph_hi = p + 1; hipLaunchKernelGGL(mk_fwd, dim3(grid), dim3(NWAVES * 64), LDS_BYTES, stream, a); }
#endif
}
```

```cpp
#include <hip/hip_runtime.h>
#include <cstdio>
#include <cstdint>
namespace pg8 {
#define PG8_LAS __attribute__((address_space(3)))
typedef unsigned short bf16_t;
typedef short bf16x8 __attribute__((ext_vector_type(8)));
typedef float f32x4 __attribute__((ext_vector_type(4)));
typedef unsigned u32x4 __attribute__((ext_vector_type(4)));
constexpr int BM = 256, BK = 64, HALF = 128, HTB = HALF * BK * 2  , STAGE_BYTES = 8 * HTB, NXCD = 8, WGM = 8;

__host__ __device__ __forceinline__ int lds_byte(int r, int c) { const int st = (r >> 4) * 2 + (c >> 5), rr = r & 15, cc = c & 31, ob = rr * 64 + cc * 2; return st * 1024 + (ob ^ (((ob >> 9) & 1) << 5)); }
__host__ __device__ __forceinline__ void stage_rc(int b, int& R, int& C) { const int st = b / 1024, sb = b % 1024, swz = sb ^ (((sb >> 9) & 1) << 5); R = (st >> 1) * 16 + swz / 64; C = (st & 1) * 32 + (swz % 64) / 2; }
__host__ __device__ __forceinline__ int perm32(int rho) { const int n = rho >> 4, i = rho & 15; return 8 * (i >> 2) + 4 * n + (i & 3); }

struct Unit { int pm, pn; };
struct Gemm { const bf16_t* A; const bf16_t* Bt; int M, N, K; };

struct StaticOrder {
    int nM, nN, nwg, G, c;
    __host__ __device__ void init(int M, int N, int G_, int c_) { nM = M / BM; nN = N / BM; nwg = nM * nN; G = G_; c = c_; }
    __host__ __device__ bool next(int i, Unit& u) const {
        const long L = (long)i * G + c; if (L >= nwg) return false;
        int wgid = (int)L; { const int q = nwg / NXCD, r = nwg % NXCD, xcd = wgid % NXCD, off = wgid / NXCD; wgid = (xcd < r ? xcd * (q + 1) : r * (q + 1) + (xcd - r) * q) + off; }
        const int nig = WGM * nN, gid = wgid / nig, fm = gid * WGM, gsz = (nM - fm) < WGM ? (nM - fm) : WGM;
        u.pm = fm + ((wgid % nig) % gsz); u.pn = (wgid % nig) / gsz; return true;
    }
    __device__ __forceinline__ void a_ready(const Unit&) const {}
    __device__ __forceinline__ void done(const Unit&) const {}
};

__device__ __forceinline__ unsigned cvt_pk_bf16(float lo, float hi) { unsigned r; asm volatile("v_cvt_pk_bf16_f32 %0, %1, %2" : "=v"(r) : "v"(lo), "v"(hi)); return r; }
typedef float f32x2 __attribute__((ext_vector_type(2)));
__device__ __forceinline__ f32x2 gelu_pk(f32x2 v) {
    const f32x2 av = __builtin_elementwise_abs(v), d = av * 0.2316418882f + 1.0f;
    f32x2 t; t.x = __builtin_amdgcn_rcpf(d.x); t.y = __builtin_amdgcn_rcpf(d.y);
    f32x2 q = t * 0.5307027145f + (-0.7265760135f); q = q * t + 0.7107068705f; q = q * t + (-0.142248368f); q = q * t + 0.127414796f; q = q * t;
    const f32x2 s = (v * v) * (-0.72134752044f);
    f32x2 e; e.x = __builtin_amdgcn_exp2f(s.x); e.y = __builtin_amdgcn_exp2f(s.y);
    const f32x2 m = v * (q * e), r = v - m;
    f32x2 o; o.x = v.x < 0.f ? m.x : r.x; o.y = v.y < 0.f ? m.y : r.y; return o;
}

template <int ACT  > struct EpiBf16 {
    static constexpr bool PERM = true, AFTER_DRAIN = false; static_assert(ACT == 0 || ACT == 1, "EpiBf16: ACT is 0 (none) or 1 (gelu_pk)");
    bf16_t* O; int ldc; const float* bias; int split_cols; size_t split_stride; float scale0;
    __device__ __forceinline__ void operator()(const f32x4 (&acc)[2][2][4][2], const Unit& u, int wr, int wc, int fr, int fq) const {
        const int row0 = u.pm * BM + wr * 64 + fr; int colt = u.pn * BM; bf16_t* base = O;
        float sc = 1.f; if (split_cols) { const int t = colt / split_cols; base += (size_t)t * split_stride; colt -= t * split_cols; if (t == 0) sc = scale0; }
        const int col0 = colt + wc * 32 + 8 * fq, bcol0 = u.pn * BM + wc * 32 + 8 * fq;
        f32x4 bv[2][2];
#pragma unroll
        for (int bj = 0; bj < 2; ++bj)
#pragma unroll
            for (int n = 0; n < 2; ++n) bv[bj][n] = bias ? *(const f32x4*)(bias + bcol0 + bj * HALF + 4 * n) : (f32x4){0.f, 0.f, 0.f, 0.f};
#pragma unroll
        for (int ai = 0; ai < 2; ++ai)
#pragma unroll
            for (int m = 0; m < 4; ++m) { bf16_t* rowp = base + (size_t)(row0 + ai * HALF + m * 16) * ldc + col0;
#pragma unroll
                for (int bj = 0; bj < 2; ++bj) { f32x4 v0 = acc[ai][bj][m][0] + bv[bj][0], v1 = acc[ai][bj][m][1] + bv[bj][1];
                    if (ACT == 1) { f32x2 a = gelu_pk((f32x2){v0[0], v0[1]}), b = gelu_pk((f32x2){v0[2], v0[3]}), c = gelu_pk((f32x2){v1[0], v1[1]}), d = gelu_pk((f32x2){v1[2], v1[3]});
                        v0 = (f32x4){a.x, a.y, b.x, b.y}; v1 = (f32x4){c.x, c.y, d.x, d.y}; }
                    v0 = v0 * sc; v1 = v1 * sc; u32x4 w; w.x = cvt_pk_bf16(v0[0], v0[1]); w.y = cvt_pk_bf16(v0[2], v0[3]); w.z = cvt_pk_bf16(v1[0], v1[1]); w.w = cvt_pk_bf16(v1[2], v1[3]);
                    *(u32x4*)(rowp + bj * HALF) = w; } }
    }
};
template <class Epi, class Sched, bool ALIGN_EPI = false, bool SP2 = false>
__device__ __forceinline__ void gemm_phase(PG8_LAS unsigned char* lds, const Gemm g, const Sched& S, const Epi& E) {
    const int tid = threadIdx.x, wid = __builtin_amdgcn_readfirstlane(tid >> 6), lane = tid & 63, wr = wid >> 2, wc = wid & 3, fr = lane & 15, fq = lane >> 4;
    const int K = g.K, nt = K / BK;
    unsigned voffA[2], voffB[2];
#pragma unroll
    for (int i = 0; i < 2; ++i) { int R, C; stage_rc(tid * 16 + i * 8192, R, C); const int Rb = Epi::PERM ? ((R & ~31) + perm32(R & 31)) : R;
        voffA[i] = (unsigned)(R * K + C) * 2u; voffB[i] = (unsigned)(Rb * K + C) * 2u; }
    const size_t kstep = (size_t)(BK * 2);
    const size_t hstep = (size_t)HALF * K * 2;
    const size_t tstep = 2 * hstep;
    const unsigned ldsw = (unsigned)wid * 1024u;
    const int aoff = lds_byte(wr * 64 + fr, fq * 8), boff = lds_byte(wc * 32 + fr, fq * 8);
#define PG8_SA(b, h) (((b) * 2 + (h)) * HTB)
#define PG8_SB(b, h) ((4 + (b) * 2 + (h)) * HTB)
#define PG8_STAGE(bufoff, gbase, voff) do { _Pragma("unroll") for (int _i = 0; _i < 2; ++_i) \
        __builtin_amdgcn_global_load_lds((const unsigned*)((const char*)(gbase) + (voff)[_i]), (PG8_LAS unsigned*)(lds + (bufoff) + ldsw + _i * 8192), 16, 0, 0); } while (0)
#define PG8_LDA(dst, b, h) do { _Pragma("unroll") for (int m = 0; m < 4; ++m) _Pragma("unroll") for (int k = 0; k < 2; ++k) dst[m][k] = *(const PG8_LAS bf16x8*)(lds + PG8_SA(b, h) + aoff + m * 2048 + k * 1024); } while (0)
#define PG8_LDB(dst, b, h) do { _Pragma("unroll") for (int n = 0; n < 2; ++n) _Pragma("unroll") for (int k = 0; k < 2; ++k) dst[n][k] = *(const PG8_LAS bf16x8*)(lds + PG8_SB(b, h) + boff + n * 2048 + k * 1024); } while (0)
#define PG8_MMA(ai, bj, At, Bt) do { __builtin_amdgcn_s_setprio(1); _Pragma("unroll") for (int m = 0; m < 4; ++m) _Pragma("unroll") for (int n = 0; n < 2; ++n) _Pragma("unroll") for (int k = 0; k < 2; ++k) \
        acc[ai][bj][m][n] = __builtin_amdgcn_mfma_f32_16x16x32_bf16(Bt[n][k], At[m][k], acc[ai][bj][m][n], 0, 0, 0); __builtin_amdgcn_s_setprio(0); } while (0)
#define PG8_WAIT_V(n) asm volatile("s_waitcnt vmcnt(" #n ")" ::: "memory")
#define PG8_WAIT_L(n) asm volatile("s_waitcnt lgkmcnt(" #n ")" ::: "memory")
#define PG8_BAR __builtin_amdgcn_s_barrier()
#define PG8_SCHED __builtin_amdgcn_sched_barrier(0)
    Unit cur, nxt; int ui = 0;
    if (!S.next(0, cur)) return;
    f32x4 acc[2][2][4][2];
    if constexpr (Epi::INIT) E.init(acc, cur, wr, wc, fr, fq); else {
#pragma unroll
    for (int a = 0; a < 2; ++a)
#pragma unroll
        for (int b = 0; b < 2; ++b)
#pragma unroll
            for (int m = 0; m < 4; ++m)
#pragma unroll
                for (int n = 0; n < 2; ++n) acc[a][b][m][n] = (f32x4){0.f, 0.f, 0.f, 0.f};
    }
    bf16x8 At[4][2], B0[2][2], B1[2][2];
    const char* cA = (const char*)g.A + (size_t)cur.pm * tstep; const char* cB = (const char*)g.Bt + (size_t)cur.pn * tstep;
    S.a_ready(cur);
    if constexpr (SP2) {
        PG8_STAGE(PG8_SB(0, 0), cB, voffB); PG8_STAGE(PG8_SB(0, 1), cB + hstep, voffB); PG8_STAGE(PG8_SA(0, 0), cA, voffA); PG8_STAGE(PG8_SA(0, 1), cA + hstep, voffA);
        if (wr == 1) PG8_BAR;
        PG8_WAIT_V(2); PG8_BAR;
        PG8_STAGE(PG8_SB(1, 0), cB + kstep, voffB); PG8_STAGE(PG8_SA(1, 0), cA + kstep, voffA); PG8_STAGE(PG8_SB(1, 1), cB + hstep + kstep, voffB);
        PG8_WAIT_V(6); PG8_BAR;
    } else {
        PG8_STAGE(PG8_SB(0, 0), cB, voffB); PG8_STAGE(PG8_SA(0, 0), cA, voffA); PG8_STAGE(PG8_SB(0, 1), cB + hstep, voffB); PG8_STAGE(PG8_SA(0, 1), cA + hstep, voffA);
        if (wr == 1) PG8_BAR;
        PG8_WAIT_V(4); PG8_BAR;
        PG8_STAGE(PG8_SB(1, 0), cB + kstep, voffB); PG8_STAGE(PG8_SA(1, 0), cA + kstep, voffA); PG8_STAGE(PG8_SB(1, 1), cB + hstep + kstep, voffB);
        PG8_WAIT_V(6); PG8_BAR;
    }
    for (;;) {
        const bool has_next = S.next(ui + 1, nxt);
        const char* nA = has_next ? (const char*)g.A + (size_t)nxt.pm * tstep : cA; const char* nB = has_next ? (const char*)g.Bt + (size_t)nxt.pn * tstep : cB;
_Pragma("unroll 1")
        for (int t = 0; t < nt; t += 2) {
            if constexpr (Epi::MIDK > 0) { if (t == Epi::MIDK) E.mid(acc, cur, wr, wc, fr, fq); }
            const bool last = (t == nt - 2);
            const char* a1 = cA + (size_t)(t + 1) * kstep;
            const char* a2 = last ? nA : cA + (size_t)(t + 2) * kstep; const char* b2 = last ? nB : cB + (size_t)(t + 2) * kstep;
            const char* a3 = a2 + kstep; const char* b3 = b2 + kstep;
            if (last && has_next) S.a_ready(nxt);
            if constexpr (SP2) {
            PG8_LDB(B0, 0, 0); PG8_LDB(B1, 0, 1); PG8_SCHED; PG8_LDA(At, 0, 0); PG8_STAGE(PG8_SA(1, 1), a1 + hstep, voffA);
            PG8_WAIT_V(8); PG8_WAIT_L(0); PG8_BAR; PG8_MMA(0, 0, At, B0); PG8_MMA(0, 1, At, B1); PG8_BAR; PG8_SCHED;
            PG8_LDA(At, 0, 1); PG8_STAGE(PG8_SB(0, 0), b2, voffB); PG8_STAGE(PG8_SB(0, 1), b2 + hstep, voffB); PG8_STAGE(PG8_SA(0, 0), a2, voffA);
            PG8_WAIT_V(8); PG8_WAIT_L(0); PG8_BAR; PG8_MMA(1, 0, At, B0); PG8_MMA(1, 1, At, B1); PG8_BAR; PG8_SCHED;
            PG8_LDB(B0, 1, 0); PG8_LDB(B1, 1, 1); PG8_SCHED; PG8_LDA(At, 1, 0); PG8_STAGE(PG8_SA(0, 1), a2 + hstep, voffA);
            PG8_WAIT_V(8); PG8_WAIT_L(0); PG8_BAR; PG8_MMA(0, 0, At, B0); PG8_MMA(0, 1, At, B1); PG8_BAR; PG8_SCHED;
            PG8_LDA(At, 1, 1); PG8_STAGE(PG8_SB(1, 0), b3, voffB); PG8_STAGE(PG8_SB(1, 1), b3 + hstep, voffB); PG8_STAGE(PG8_SA(1, 0), a3, voffA);
            PG8_WAIT_V(8); PG8_WAIT_L(0); PG8_BAR; PG8_MMA(1, 0, At, B0); PG8_MMA(1, 1, At, B1); PG8_BAR; PG8_SCHED;
            } else {
            PG8_LDB(B0, 0, 0); PG8_SCHED; PG8_LDA(At, 0, 0); PG8_STAGE(PG8_SA(1, 1), a1 + hstep, voffA);
            PG8_WAIT_L(8); PG8_BAR; PG8_WAIT_L(0); PG8_MMA(0, 0, At, B0); PG8_BAR; PG8_SCHED;
            PG8_LDB(B1, 0, 1); PG8_STAGE(PG8_SB(0, 0), b2, voffB);
            PG8_BAR; PG8_WAIT_L(0); PG8_MMA(0, 1, At, B1); PG8_BAR;
            PG8_LDA(At, 0, 1); PG8_STAGE(PG8_SA(0, 0), a2, voffA);
            PG8_BAR; PG8_WAIT_L(0); PG8_MMA(1, 0, At, B0); PG8_BAR; PG8_SCHED;
            PG8_STAGE(PG8_SB(0, 1), b2 + hstep, voffB);
            PG8_WAIT_V(6); PG8_BAR; PG8_MMA(1, 1, At, B1); PG8_BAR;
            PG8_LDB(B0, 1, 0); PG8_SCHED; PG8_LDA(At, 1, 0); PG8_STAGE(PG8_SA(0, 1), a2 + hstep, voffA);
            PG8_WAIT_L(8); PG8_BAR; PG8_WAIT_L(0); PG8_MMA(0, 0, At, B0); PG8_BAR; PG8_SCHED;
            PG8_LDB(B1, 1, 1); PG8_STAGE(PG8_SB(1, 0), b3, voffB);
            PG8_BAR; PG8_WAIT_L(0); PG8_MMA(0, 1, At, B1); PG8_BAR;
            PG8_LDA(At, 1, 1); PG8_STAGE(PG8_SA(1, 0), a3, voffA);
            PG8_BAR; PG8_WAIT_L(0); PG8_MMA(1, 0, At, B0); PG8_BAR; PG8_SCHED;
            PG8_STAGE(PG8_SB(1, 1), b3 + hstep, voffB);
            PG8_WAIT_V(6); PG8_BAR; PG8_MMA(1, 1, At, B1); PG8_BAR;
            }
        }
        if constexpr (ALIGN_EPI) { if (wr == 0) PG8_BAR; }
        if constexpr (!Epi::AFTER_DRAIN) { E(acc, cur, wr, wc, fr, fq); S.done(cur); }
        if (!has_next) break;
        if constexpr (Epi::INIT) E.init(acc, nxt, wr, wc, fr, fq); else {
#pragma unroll
        for (int a = 0; a < 2; ++a)
#pragma unroll
            for (int b = 0; b < 2; ++b)
#pragma unroll
                for (int m = 0; m < 4; ++m)
#pragma unroll
                    for (int n = 0; n < 2; ++n) acc[a][b][m][n] = (f32x4){0.f, 0.f, 0.f, 0.f};
        }
        cur = nxt; cA = nA; cB = nB; ++ui;
        if constexpr (ALIGN_EPI) { if (wr == 1) PG8_BAR; }
    }
    PG8_WAIT_V(0);
    if constexpr (!ALIGN_EPI) { if (wr == 0) PG8_BAR; }
    PG8_BAR;
    if constexpr (Epi::AFTER_DRAIN) { E.fused(acc, cur, wr, wc, fr, fq, lds, wid, lane); S.done(cur); }
#undef PG8_SA
#undef PG8_SB
#undef PG8_STAGE
#undef PG8_LDA
#undef PG8_LDB
#undef PG8_MMA
#undef PG8_WAIT_V
#undef PG8_WAIT_L
#undef PG8_BAR
#undef PG8_SCHED
}
}

#include <hip/hip_cooperative_groups.h>
namespace cg = cooperative_groups;

#ifndef SKEW1
#define SKEW1 0
#define SKEW3 0
#define SKEW4 0
#define SKEW5 0
#define SKEW6 0
#endif
#ifndef MK_ONE_LAUNCH
#define MK_ONE_LAUNCH 1
#endif

#define LAS __attribute__((address_space(3)))
typedef unsigned short bf16;
typedef float f32x4 __attribute__((ext_vector_type(4)));
typedef float f32x16 __attribute__((ext_vector_type(16)));
typedef unsigned u32x4 __attribute__((ext_vector_type(4)));
typedef unsigned u32x2 __attribute__((ext_vector_type(2)));
typedef short bf16x8 __attribute__((ext_vector_type(8)));
typedef short s16x4 __attribute__((ext_vector_type(4)));

constexpr int NWAVES = 8;
constexpr int SEQ = 2048, DM = 1024, NB = 48, T = NB * SEQ;
constexpr int ZW = 2816, GW = 2048, FF = 2816;
constexpr int N1 = ZW + GW;
constexpr float EPS = 1e-6f;
constexpr int LDS_BYTES = 147456, RING_BYTES = 131072;

constexpr size_t MiB = 1u << 20;
constexpr size_t WS_W1T = 1 * MiB, WS_WPT = 11 * MiB, WS_WUAT = 12 * MiB, WS_WOT = 13 * MiB, WS_WGUT = 15 * MiB, WS_WDT = 26 * MiB;
constexpr size_t WS_ROPE = 32 * MiB, WS_SSQ2 = 34 * MiB, WS_SLOTS = 40 * MiB, WS_CNT = 44 * MiB;
constexpr size_t WS_XB = 48 * MiB;
constexpr size_t WS_PM = WS_XB;
constexpr int PMW = 768;
constexpr size_t WS_Z = 240 * MiB;
constexpr size_t WS_END = 768 * MiB;

__device__ __forceinline__ unsigned f2bf(float f) { unsigned u = __builtin_bit_cast(unsigned, f); return (u + 0x7fffu + ((u >> 16) & 1u)) >> 16; }
typedef __bf16 bf16x2_g __attribute__((ext_vector_type(2))); typedef float f32x2_g __attribute__((ext_vector_type(2)));
__device__ __forceinline__ unsigned pk2(float lo, float hi) { const f32x2_g v = {lo, hi}; return __builtin_bit_cast(unsigned, __builtin_convertvector(v, bf16x2_g)); }
__device__ __forceinline__ float bflo(unsigned w) { return __builtin_bit_cast(float, w << 16); }
__device__ __forceinline__ float bfhi(unsigned w) { return __builtin_bit_cast(float, w & 0xffff0000u); }
__device__ __forceinline__ float wave_sum(float v) {
#pragma unroll
    for (int o = 1; o < 64; o <<= 1) v += __shfl_xor(v, o);
    return v;
}
__device__ __forceinline__ float sigmoidf_(float x) { return __builtin_amdgcn_rcpf(1.0f + __builtin_amdgcn_exp2f(x * -1.4426950408889634f)); }
__device__ __forceinline__ void skew_wait(unsigned ticks) { if (ticks) { const unsigned long long t0 = __builtin_amdgcn_s_memrealtime(); while (__builtin_amdgcn_s_memrealtime() - t0 < ticks) __builtin_amdgcn_s_sleep(4); } }

namespace ep {
using pg8::Unit; using pg8::cvt_pk_bf16;
constexpr int BM = 256, HALF = 128;

typedef __bf16 bf16x2_t __attribute__((ext_vector_type(2)));
typedef float f32x2_t __attribute__((ext_vector_type(2)));
__device__ __forceinline__ unsigned cvt2(float a, float b) { const f32x2_t v = {a, b}; return __builtin_bit_cast(unsigned, __builtin_convertvector(v, bf16x2_t)); }
__device__ __forceinline__ u32x4 pack8(const f32x4 v0, const f32x4 v1) {
    u32x4 w; w.x = cvt2(v0[0], v0[1]); w.y = cvt2(v0[2], v0[3]); w.z = cvt2(v1[0], v1[1]); w.w = cvt2(v1[2], v1[3]); return w;
}
__device__ __forceinline__ void unpack8(const u32x4 w, f32x4& v0, f32x4& v1) {
    v0 = (f32x4){bflo(w.x), bfhi(w.x), bflo(w.y), bfhi(w.y)}; v1 = (f32x4){bflo(w.z), bfhi(w.z), bflo(w.w), bfhi(w.w)};
}

struct EpiZG {
    static constexpr bool PERM = true, AFTER_DRAIN = false, INIT = false; static constexpr int MIDK = 0;
    bf16* Z; bf16* G; const LAS float* bias; const float* rope;
    __device__ __forceinline__ bf16* zptr(int pn, int bj, int wc, int fq, int row) const {
        if (pn < 2) return Z + (size_t)row * 512 + pn * BM + wc * 64 + bj * 32 + 8 * fq;
        const int hidx = (pn - 2) * 4 + wc, sh = 2 * ((hidx % 12) >> 2), tok = row & (SEQ - 1);
        const int pos = ((tok & ((1 << sh) - 1)) << (11 - sh)) | (tok >> sh);
        return Z + (size_t)T * 512 + ((size_t)((((row >> 11) * 36 + hidx) << 11) + pos) << 6) + bj * 32 + 8 * fq;
    }
    __device__ __forceinline__ void operator()(const f32x4 (&acc)[2][2][4][2], const Unit& u, int wr, int wc, int fr_in, int fq_in) const {
        int fr = fr_in, fq = fq_in; asm volatile("" : "+v"(fr), "+v"(fq));
        const int row0 = u.pm * BM + wr * 64 + fr;
        const int cl = wc * 64 + 8 * fq;
        if (u.pn >= 11) {
            const int gc0 = (u.pn - 11) * BM + cl;
            f32x4 bv[2][2];
#pragma unroll
            for (int bj = 0; bj < 2; ++bj)
#pragma unroll
                for (int n = 0; n < 2; ++n) bv[bj][n] = *(const LAS f32x4*)(bias + gc0 + bj * 32 + 4 * n);
#pragma unroll
            for (int ai = 0; ai < 2; ++ai)
#pragma unroll
                for (int m = 0; m < 4; ++m) { bf16* rowp = G + (size_t)(row0 + ai * HALF + m * 16) * GW + gc0;
#pragma unroll
                    for (int bj = 0; bj < 2; ++bj) { f32x4 v0 = acc[ai][bj][m][0] * -1.4426950408889634f + bv[bj][0], v1 = acc[ai][bj][m][1] * -1.4426950408889634f + bv[bj][1];
#pragma unroll
                        for (int j = 0; j < 4; ++j) { v0[j] = __builtin_amdgcn_rcpf(1.0f + __builtin_amdgcn_exp2f(v0[j])); v1[j] = __builtin_amdgcn_rcpf(1.0f + __builtin_amdgcn_exp2f(v1[j])); }
                        *(u32x4*)(rowp + bj * 32) = pack8(v0, v1); }
                    asm volatile("" ::: "memory"); }
        } else {
            const bool rope_tile = (u.pn >= 2 && u.pn < 8);
            const float sc = (u.pn >= 2 && u.pn < 5) ? 0.18033688011112042f : 1.0f;
            if (rope_tile) {
                const float sgn = (fq == 0) ? -1.0f : 1.0f; const bool act = fq < 2;
#pragma unroll
                for (int am = 0; am < 4; ++am) { const int ai = am >> 1;
                    f32x4 tb[2][4];
#pragma unroll
                    for (int mm = 0; mm < 2; ++mm) { const int m = (am & 1) * 2 + mm; const int row = row0 + ai * HALF + m * 16; const f32x4* tp = (const f32x4*)(rope + (row & (SEQ - 1)) * 16);
#pragma unroll
                        for (int k = 0; k < 4; ++k) tb[mm][k] = tp[k]; }
#pragma unroll
                    for (int mm = 0; mm < 2; ++mm) { const int m = (am & 1) * 2 + mm; const int row = row0 + ai * HALF + m * 16;
                        const f32x4 c0 = tb[mm][0], c1 = tb[mm][1], s0 = tb[mm][2] * sgn, s1 = tb[mm][3] * sgn;
                        f32x4 v0 = acc[ai][0][m][0], v1 = acc[ai][0][m][1], p0, p1;
#pragma unroll
                        for (int j = 0; j < 4; ++j) { p0[j] = __shfl_xor(v0[j], 16); p1[j] = __shfl_xor(v1[j], 16); }
                        if (act) { v0 = v0 * c0 + p0 * s0; v1 = v1 * c1 + p1 * s1; }
                        *(u32x4*)zptr(u.pn, 0, wc, fq, row) = pack8(v0 * sc, v1 * sc);
                        *(u32x4*)zptr(u.pn, 1, wc, fq, row) = pack8(acc[ai][1][m][0] * sc, acc[ai][1][m][1] * sc); }
                    asm volatile("" ::: "memory"); }
            } else {
#pragma unroll
                for (int ai = 0; ai < 2; ++ai)
#pragma unroll
                    for (int m = 0; m < 4; ++m) { const int row = row0 + ai * HALF + m * 16;
#pragma unroll
                        for (int bj = 0; bj < 2; ++bj) *(u32x4*)zptr(u.pn, bj, wc, fq, row) = pack8(acc[ai][bj][m][0] * sc, acc[ai][bj][m][1] * sc); }
            }
        }
    }
};

struct EpiGateCat {
    static constexpr bool PERM = true, AFTER_DRAIN = false, INIT = false; static constexpr int MIDK = 8;
    bf16* MB; const bf16* G;
    __device__ __forceinline__ void mid(f32x4 (&acc)[2][2][4][2], const Unit& u, int wr, int wc, int fr_in, int fq_in) const {
        int fr = fr_in, fq = fq_in; asm volatile("" : "+v"(fr), "+v"(fq));
        const int row0 = u.pm * BM + wr * 64 + fr, col0 = u.pn * BM + wc * 64 + 8 * fq;
#pragma unroll
        for (int ai = 0; ai < 2; ++ai) {
            u32x4 ga[4][2], gb[4][2];
#pragma unroll
            for (int m = 0; m < 4; ++m) { const bf16* gp = G + (size_t)(row0 + ai * HALF + m * 16) * GW + col0;
#pragma unroll
                for (int bj = 0; bj < 2; ++bj) { ga[m][bj] = *(const u32x4*)(gp + bj * 32); gb[m][bj] = *(const u32x4*)(gp + DM + bj * 32); } }
#pragma unroll
            for (int m = 0; m < 4; ++m)
#pragma unroll
                for (int bj = 0; bj < 2; ++bj) { f32x4 a0, a1, b0, b1; unpack8(ga[m][bj], a0, a1); unpack8(gb[m][bj], b0, b1);
#pragma unroll
                    for (int j = 0; j < 4; ++j) { a0[j] *= __builtin_amdgcn_rcpf(fmaxf(b0[j], 1e-30f)); a1[j] *= __builtin_amdgcn_rcpf(fmaxf(b1[j], 1e-30f)); }
                    acc[ai][bj][m][0] *= a0; acc[ai][bj][m][1] *= a1; }
            asm volatile("" ::: "memory"); }
    }
    __device__ __forceinline__ void operator()(const f32x4 (&acc)[2][2][4][2], const Unit& u, int wr, int wc, int fr_in, int fq_in) const {
        int fr = fr_in, fq = fq_in; asm volatile("" : "+v"(fr), "+v"(fq));
        const int row0 = u.pm * BM + wr * 64 + fr, col0 = u.pn * BM + wc * 64 + 8 * fq;
        u32x4 gb[2][4][2];
#pragma unroll
        for (int ai = 0; ai < 2; ++ai)
#pragma unroll
            for (int m = 0; m < 4; ++m)
#pragma unroll
                for (int bj = 0; bj < 2; ++bj) gb[ai][m][bj] = *(const u32x4*)(G + (size_t)(row0 + ai * HALF + m * 16) * GW + DM + col0 + bj * 32);
#pragma unroll
        for (int ai = 0; ai < 2; ++ai)
#pragma unroll
            for (int m = 0; m < 4; ++m)
#pragma unroll
                for (int bj = 0; bj < 2; ++bj) { f32x4 b0, b1; unpack8(gb[ai][m][bj], b0, b1);
                    *(u32x4*)(MB + (size_t)(row0 + ai * HALF + m * 16) * DM + col0 + bj * 32) = pack8(acc[ai][bj][m][0] * b0, acc[ai][bj][m][1] * b1); }
    }
};

struct EpiRes {
    static constexpr bool PERM = true, AFTER_DRAIN = false, INIT = true; static constexpr int MIDK = 0;
    const float* base_lo; const float* base_hi; bf16* XB_; float* ssq; LAS float* red;
    __device__ __forceinline__ void init(f32x4 (&acc)[2][2][4][2], const Unit& u, int wr, int wc, int fr_in, int fq_in) const {
        int fr = fr_in, fq = fq_in; asm volatile("" : "+v"(fr), "+v"(fq));
        const int row0 = u.pm * BM + wr * 64 + fr, col0 = u.pn * BM + wc * 64 + 8 * fq;
        const float* base = (u.pm < 256) ? base_lo : base_hi;
#pragma unroll
        for (int ai = 0; ai < 2; ++ai)
#pragma unroll
            for (int m = 0; m < 4; ++m)
#pragma unroll
                for (int bj = 0; bj < 2; ++bj) { const size_t off = (size_t)(row0 + ai * HALF + m * 16) * DM + col0 + bj * 32;
                    acc[ai][bj][m][0] = *(const f32x4*)(base + off); acc[ai][bj][m][1] = *(const f32x4*)(base + off + 4); }
    }
    __device__ __forceinline__ void operator()(const f32x4 (&acc)[2][2][4][2], const Unit& u, int wr, int wc, int fr_in, int fq_in) const {
        int fr = fr_in, fq = fq_in; asm volatile("" : "+v"(fr), "+v"(fq));
        const int row0 = u.pm * BM + wr * 64 + fr, col0 = u.pn * BM + wc * 64 + 8 * fq;
#pragma unroll
        for (int ai = 0; ai < 2; ++ai)
#pragma unroll
            for (int m = 0; m < 4; ++m) { const size_t row = (size_t)(row0 + ai * HALF + m * 16); float q = 0.f;
#pragma unroll
                for (int bj = 0; bj < 2; ++bj) { const size_t off = row * DM + col0 + bj * 32;
                    const f32x4 v0 = acc[ai][bj][m][0], v1 = acc[ai][bj][m][1];
                    *(u32x4*)(XB_ + off) = pack8(v0, v1);
                    q += (v0[0] * v0[0] + v0[1] * v0[1]) + (v0[2] * v0[2] + v0[3] * v0[3]) + (v1[0] * v1[0] + v1[1] * v1[1]) + (v1[2] * v1[2] + v1[3] * v1[3]); }
                q += __shfl_xor(q, 16); q += __shfl_xor(q, 32); if (fq == 0) red[wc * 256 + ai * HALF + wr * 64 + m * 16 + fr] = q; }
        asm volatile("s_waitcnt lgkmcnt(0)" ::: "memory"); __builtin_amdgcn_s_barrier(); asm volatile("" ::: "memory");
        const int t = threadIdx.x;
        if (t < 256) ssq[(size_t)(u.pm * BM + t) * 4 + u.pn] = (red[t] + red[256 + t]) + (red[512 + t] + red[768 + t]);
    }
};

struct EpiFinal {
    static constexpr bool PERM = true, AFTER_DRAIN = false, INIT = true; static constexpr int MIDK = 0;
    float* out; const bf16* X1; const float* gfin; unsigned* slots; unsigned* cnt; LAS float* red;
    __device__ __forceinline__ void init(f32x4 (&acc)[2][2][4][2], const Unit& u, int wr, int wc, int fr_in, int fq_in) const {
        int fr = fr_in, fq = fq_in; asm volatile("" : "+v"(fr), "+v"(fq));
        const int row0 = u.pm * BM + wr * 64 + fr, col0 = u.pn * BM + wc * 64 + 8 * fq;
        u32x4 w[2][4][2];
#pragma unroll
        for (int ai = 0; ai < 2; ++ai)
#pragma unroll
            for (int m = 0; m < 4; ++m)
#pragma unroll
                for (int bj = 0; bj < 2; ++bj) w[ai][m][bj] = *(const u32x4*)(X1 + (size_t)(row0 + ai * HALF + m * 16) * DM + col0 + bj * 32);
#pragma unroll
        for (int ai = 0; ai < 2; ++ai)
#pragma unroll
            for (int m = 0; m < 4; ++m)
#pragma unroll
                for (int bj = 0; bj < 2; ++bj) unpack8(w[ai][m][bj], acc[ai][bj][m][0], acc[ai][bj][m][1]);
    }
    __device__ __forceinline__ void operator()(const f32x4 (&acc)[2][2][4][2], const Unit& u, int wr, int wc, int fr_in, int fq_in) const {
        int fr = fr_in, fq = fq_in; asm volatile("" : "+v"(fr), "+v"(fq));
        const int row0 = u.pm * BM + wr * 64 + fr, col0 = u.pn * BM + wc * 64 + 8 * fq, t = threadIdx.x;
        f32x4 gv[2][2];
#pragma unroll
        for (int bj = 0; bj < 2; ++bj)
#pragma unroll
            for (int n = 0; n < 2; ++n) gv[bj][n] = *(const f32x4*)(gfin + col0 + bj * 32 + 4 * n);
#pragma unroll
        for (int ai = 0; ai < 2; ++ai)
#pragma unroll
            for (int m = 0; m < 4; ++m) { float q = 0.f;
#pragma unroll
                for (int bj = 0; bj < 2; ++bj) { const f32x4 v0 = acc[ai][bj][m][0], v1 = acc[ai][bj][m][1];
                    q += (v0[0] * v0[0] + v0[1] * v0[1]) + (v0[2] * v0[2] + v0[3] * v0[3]) + (v1[0] * v1[0] + v1[1] * v1[1]) + (v1[2] * v1[2] + v1[3] * v1[3]); }
                q += __shfl_xor(q, 16); q += __shfl_xor(q, 32); if (fq == 0) red[wc * 256 + ai * HALF + wr * 64 + m * 16 + fr] = q; }
        asm volatile("s_waitcnt lgkmcnt(0)" ::: "memory"); __builtin_amdgcn_s_barrier(); asm volatile("" ::: "memory");
        if (t < 256) { const float s = (red[t] + red[256 + t]) + (red[512 + t] + red[768 + t]);
            __hip_atomic_store(slots + (size_t)(u.pm * BM + t) * 4 + u.pn, __builtin_bit_cast(unsigned, s), __ATOMIC_RELAXED, __HIP_MEMORY_SCOPE_AGENT); }
        asm volatile("s_waitcnt vmcnt(0)" ::: "memory");
        __builtin_amdgcn_s_barrier(); asm volatile("" ::: "memory");
        if (t == 0) { unsigned* c = cnt + 64 * u.pm;
            __hip_atomic_fetch_add(c, 1u, __ATOMIC_RELAXED, __HIP_MEMORY_SCOPE_AGENT);
            unsigned sp = 0;
            while (__hip_atomic_load(c, __ATOMIC_RELAXED, __HIP_MEMORY_SCOPE_AGENT) < 4u) { __builtin_amdgcn_s_sleep(1); if (++sp > (1u << 24)) break; }
            __builtin_amdgcn_fence(__ATOMIC_ACQUIRE, "agent"); }
        asm volatile("s_waitcnt vmcnt(0) lgkmcnt(0)" ::: "memory"); __builtin_amdgcn_s_barrier(); asm volatile("" ::: "memory");
        if (t < 256) { const unsigned* sl = slots + (size_t)(u.pm * BM + t) * 4; float s = 0.f;
#pragma unroll
            for (int k = 0; k < 4; ++k) s += __builtin_bit_cast(float, __hip_atomic_load(sl + k, __ATOMIC_RELAXED, __HIP_MEMORY_SCOPE_AGENT));
            red[1024 + t] = 1.0f / sqrtf(s * (1.0f / DM) + EPS); }
        asm volatile("s_waitcnt lgkmcnt(0)" ::: "memory"); __builtin_amdgcn_s_barrier(); asm volatile("" ::: "memory");
#pragma unroll
        for (int ai = 0; ai < 2; ++ai)
#pragma unroll
            for (int m = 0; m < 4; ++m) { const int rl = ai * HALF + wr * 64 + m * 16 + fr; const float r = red[1024 + rl];
#pragma unroll
                for (int bj = 0; bj < 2; ++bj) { const size_t off = (size_t)(u.pm * BM + rl) * DM + col0 + bj * 32;
                    *(f32x4*)(out + off) = acc[ai][bj][m][0] * r * gv[bj][0]; *(f32x4*)(out + off + 4) = acc[ai][bj][m][1] * r * gv[bj][1]; }
                asm volatile("" ::: "memory"); }
    }
};

struct EpiSwiGLU {
    static constexpr bool PERM = true, AFTER_DRAIN = false, INIT = false; static constexpr int MIDK = 0;
    bf16* ACT; const float* ssq;
    __device__ __forceinline__ void operator()(const f32x4 (&acc)[2][2][4][2], const Unit& u, int wr, int wc, int fr_in, int fq_in) const {
        int fr = fr_in, fq = fq_in; asm volatile("" : "+v"(fr), "+v"(fq));
        const int row0 = u.pm * BM + wr * 64 + fr, col0 = u.pn * HALF + wc * 32 + 8 * fq;
        f32x4 sv[2][4];
#pragma unroll
        for (int ai = 0; ai < 2; ++ai)
#pragma unroll
            for (int m = 0; m < 4; ++m) sv[ai][m] = *(const f32x4*)(ssq + (size_t)(row0 + ai * HALF + m * 16) * 4);
#pragma unroll
        for (int ai = 0; ai < 2; ++ai)
#pragma unroll
            for (int m = 0; m < 4; ++m) { const size_t row = (size_t)(row0 + ai * HALF + m * 16); const f32x4 s4 = sv[ai][m];
                const float rstd = __builtin_amdgcn_rsqf(((s4[0] + s4[1]) + (s4[2] + s4[3])) * (1.0f / DM) + EPS);
                const float rl = rstd * -1.4426950408889634f, r2 = rstd * rstd;
                f32x4 t0 = acc[ai][0][m][0] * rl, t1 = acc[ai][0][m][1] * rl, g0 = acc[ai][0][m][0] * acc[ai][1][m][0], g1 = acc[ai][0][m][1] * acc[ai][1][m][1];
#pragma unroll
                for (int j = 0; j < 4; ++j) { t0[j] = __builtin_amdgcn_rcpf(1.0f + __builtin_amdgcn_exp2f(t0[j])); t1[j] = __builtin_amdgcn_rcpf(1.0f + __builtin_amdgcn_exp2f(t1[j])); }
                g0 = g0 * (t0 * r2); g1 = g1 * (t1 * r2);
                *(u32x4*)(ACT + row * FF + col0) = pack8(g0, g1); }
    }
};
struct EpiDry {
    static constexpr bool PERM = true, AFTER_DRAIN = false, INIT = false; static constexpr int MIDK = 0;
    float* sink;
    __device__ __forceinline__ void operator()(const f32x4 (&acc)[2][2][4][2], const Unit& u, int wr, int wc, int fr_in, int fq_in) const {
        int fr = fr_in, fq = fq_in; asm volatile("" : "+v"(fr), "+v"(fq));
        f32x4 s = (f32x4){0.f, 0.f, 0.f, 0.f};
#pragma unroll
        for (int ai = 0; ai < 2; ++ai)
#pragma unroll
            for (int bj = 0; bj < 2; ++bj)
#pragma unroll
                for (int m = 0; m < 4; ++m) { s += acc[ai][bj][m][0]; s += acc[ai][bj][m][1]; }
        const float t = (s[0] + s[1]) + (s[2] + s[3]);
        if (t == 1.2345e30f) sink[threadIdx.x] = t;
    }
};
}

__device__ __forceinline__ void p0_transpose_item(const float* W, int K, int N, bf16* WT, int mode, int row_off, const float* gain, LAS float* scr, int item, int lane, int pitch = 0, int koff = 0) {
    if (pitch == 0) pitch = K;
    const int nblk = N / 32, kb = item / nblk, nb = item % nblk, k0 = 64 * kb, n0 = 32 * nb;
    { f32x4 wv[8]; float gv[8];
#pragma unroll
      for (int i = 0; i < 8; ++i) { const int kk = (lane >> 3) + 8 * i; wv[i] = *(const f32x4*)(W + (size_t)(k0 + kk) * N + n0 + (lane & 7) * 4); gv[i] = gain ? gain[k0 + kk] : 1.0f; }
#pragma unroll
      for (int i = 0; i < 8; ++i) { const int kk = (lane >> 3) + 8 * i; LAS float* d = scr + kk * 33 + (lane & 7) * 4; d[0] = wv[i].x * gv[i]; d[1] = wv[i].y * gv[i]; d[2] = wv[i].z * gv[i]; d[3] = wv[i].w * gv[i]; } }
    asm volatile("s_waitcnt lgkmcnt(0)" ::: "memory");
    const int c = lane & 7;
#pragma unroll
    for (int j = 0; j < 4; ++j) { const int n = (lane >> 3) + 8 * j; const LAS float* s = scr + (8 * c) * 33 + n;
        u32x4 o; o.x = pk2(s[0 * 33], s[1 * 33]); o.y = pk2(s[2 * 33], s[3 * 33]); o.z = pk2(s[4 * 33], s[5 * 33]); o.w = pk2(s[6 * 33], s[7 * 33]);
        const int col = n0 + n; int orow;
        if (mode == 1) orow = ((col >> 7) << 8) + (col & 127) + row_off;
        else if (mode == 2) { const int a = col & 255; orow = col - a + 128 * ((a >> 5) & 1) + 32 * (a >> 6) + (a & 31); }
        else if (mode == 3) { const int a = col & 255; orow = (col & ~255) + 128 * ((a >> 5) & 1) + 32 * (a >> 6) + (a & 31) + row_off; }
        else orow = col + row_off;
        *(u32x4*)(WT + (size_t)orow * pitch + koff + k0 + 8 * c) = o; }
    asm volatile("s_waitcnt lgkmcnt(0)" ::: "memory");
}

#define MFMA32(a, b, c) __builtin_amdgcn_mfma_f32_32x32x16_bf16((a), (b), (c), 0, 0, 0)
__device__ __forceinline__ int crow(int reg, int h) { return (reg & 3) + 8 * (reg >> 2) + 4 * h; }
__device__ __forceinline__ bf16x8 pack_step(const f32x16& x, int s) {
    u32x4 p;
    asm volatile("v_cvt_pk_bf16_f32 %0, %4, %5\n\tv_cvt_pk_bf16_f32 %1, %6, %7\n\tv_cvt_pk_bf16_f32 %2, %8, %9\n\tv_cvt_pk_bf16_f32 %3, %10, %11\n\ts_nop 1"
                 : "=&v"(p[0]), "=&v"(p[1]), "=&v"(p[2]), "=&v"(p[3])
                 : "v"(x[8 * s]), "v"(x[8 * s + 1]), "v"(x[8 * s + 2]), "v"(x[8 * s + 3]), "v"(x[8 * s + 4]), "v"(x[8 * s + 5]), "v"(x[8 * s + 6]), "v"(x[8 * s + 7]));
    return __builtin_bit_cast(bf16x8, p);
}
__device__ __forceinline__ void tr_read4(unsigned a, s16x4& lo0, s16x4& hi0, s16x4& lo1, s16x4& hi1) {
    asm volatile("ds_read_b64_tr_b16 %0, %4\n\tds_read_b64_tr_b16 %1, %4 offset:1152\n\tds_read_b64_tr_b16 %2, %4 offset:64\n\tds_read_b64_tr_b16 %3, %4 offset:1216\n\ts_waitcnt lgkmcnt(0)"
                 : "=&v"(lo0), "=&v"(hi0), "=&v"(lo1), "=&v"(hi1) : "v"(a) : "memory");
}
constexpr int AT_OPITCH = 128, AT_LSE_OFF = 512 * AT_OPITCH, AT_VST_OFF = AT_LSE_OFF + 2048, AT_VPITCH = 144, AT_VST_BYTES = 32 * AT_VPITCH;
static_assert(AT_VST_OFF + NWAVES * AT_VST_BYTES <= RING_BYTES, "attention LDS");
static_assert(8 * AT_VPITCH == 1152, "tr_read4 offsets");

__device__ __forceinline__ void attn_unit(LAS unsigned char* lds, const bf16* Z, bf16* MERGED, int b, int hq, int chunk, int wid, int lane, int tid) {
    const int r32 = lane & 31, h = lane >> 5;
    const bf16* zb = Z + (size_t)T * 512 + (size_t)b * 36 * SEQ * 64;
    LAS unsigned char* vst = lds + AT_VST_OFF + wid * AT_VST_BYTES;
    LAS float* LSE = (LAS float*)(lds + AT_LSE_OFF);
    const float NEG = -INFINITY;
#pragma unroll 1
    for (int g = 0; g < 3; ++g) {
        const int sh = 2 * g, d = 1 << sh, bpr = 16 >> sh, n = SEQ >> sh, hg = 4 * g + hq;
#pragma unroll 1
        for (int wbi = 0; wbi < 2; ++wbi) {
            const int wb = wid * 2 + wbi, r = wb / bpr, q0 = chunk * (512 >> sh) + 32 * (wb % bpr);
            const int qtok = (q0 + r32) * d + r;
            const int lrow = lane >> 3, lchk = lane & 7;
            const char* qb_ = (const char*)(zb + ((size_t)((hg << 11) + r * n) << 6));
            const char* kb_ = (const char*)(zb + ((size_t)(((12 + hg) << 11) + r * n) << 6));
            const char* vb_ = (const char*)(zb + ((size_t)(((24 + hg) << 11) + r * n) << 6));
            const unsigned toff = (unsigned)(lrow * 128 + lchk * 16), qoff = (unsigned)((q0 + r32) * 128 + 16 * h);
            bf16x8 qf[4];
#pragma unroll
            for (int s = 0; s < 4; ++s) qf[s] = __builtin_bit_cast(bf16x8, *(const u32x4*)(qb_ + qoff + 32 * s));
            bool tvv[5]; int jt[5];
#pragma unroll
            for (int c = 0; c < 5; ++c) { const int j0 = q0 - 64 + 32 * c; tvv[c] = (j0 >= 0 && j0 < n); jt[c] = tvv[c] ? j0 : q0; }
            u32x4 kr[5][4];
#pragma unroll
            for (int c = 0; c < 5; ++c)
#pragma unroll
                for (int i = 0; i < 4; ++i) kr[c][i] = *(const u32x4*)(kb_ + (size_t)((jt[c] + 8 * i) * 128) + toff);
            f32x16 S[5];
#pragma unroll
            for (int c = 0; c < 5; ++c) {
#pragma unroll
                for (int i = 0; i < 4; ++i) *(LAS u32x4*)(vst + (8 * i + lrow) * AT_VPITCH + lchk * 16) = kr[c][i];
                bf16x8 kf[4];
#pragma unroll
                for (int s = 0; s < 4; ++s) kf[s] = __builtin_bit_cast(bf16x8, *(const LAS u32x4*)(vst + r32 * AT_VPITCH + 32 * s + 16 * h));
                f32x16 a;
#pragma unroll
                for (int i = 0; i < 16; ++i) a[i] = 0.f;
#pragma unroll
                for (int s = 0; s < 4; ++s) a = MFMA32(kf[s], qf[s], a);
#pragma unroll
                for (int i = 0; i < 16; ++i) { if (c == 0) a[i] = (crow(i, h) >= r32) ? a[i] : NEG; if (c == 4) a[i] = (crow(i, h) <= r32) ? a[i] : NEG; }
                S[c] = a;
            }
            asm volatile("" ::: "memory");
            u32x4 v4[5][4];
#pragma unroll
            for (int c = 0; c < 3; ++c)
#pragma unroll
                for (int i = 0; i < 4; ++i) v4[c][i] = *(const u32x4*)(vb_ + (size_t)((jt[c] + 8 * i) * 128) + toff);
            float mx = NEG;
#pragma unroll
            for (int c = 0; c < 5; ++c) { float tm = NEG;
#pragma unroll
                for (int i = 0; i < 16; ++i) tm = fmaxf(tm, S[c][i]);
                mx = fmaxf(mx, tvv[c] ? tm : NEG); }
            mx = fmaxf(mx, __shfl_xor(mx, 32));
            float den = 0.f;
#pragma unroll
            for (int c = 0; c < 5; ++c) { const float mxs = tvv[c] ? mx : INFINITY;
#pragma unroll
                for (int i = 0; i < 16; ++i) { const float p = __builtin_amdgcn_exp2f(S[c][i] - mxs); S[c][i] = p; den += p; } }
            den += __shfl_xor(den, 32);
            f32x16 O0, O1;
#pragma unroll
            for (int i = 0; i < 16; ++i) { O0[i] = 0.f; O1[i] = 0.f; }
            const unsigned trbase = (unsigned)(size_t)vst + (4 * h + ((lane & 15) >> 2)) * AT_VPITCH + 32 * ((lane >> 4) & 1) + 8 * (lane & 3);
#pragma unroll
            for (int c = 0; c < 5; ++c) {
#pragma unroll
                for (int i = 0; i < 4; ++i) *(LAS u32x4*)(vst + (8 * i + lrow) * AT_VPITCH + lchk * 16) = v4[c][i];
                if (c == 1) {
#pragma unroll
                    for (int c2 = 3; c2 < 5; ++c2)
#pragma unroll
                        for (int i = 0; i < 4; ++i) v4[c2][i] = *(const u32x4*)(vb_ + (size_t)((jt[c2] + 8 * i) * 128) + toff);
                }
                asm volatile("s_waitcnt lgkmcnt(0)" ::: "memory");
#pragma unroll
                for (int s = 0; s < 2; ++s) {
                    const bf16x8 pf = pack_step(S[c], s);
                    s16x4 lo0, hi0, lo1, hi1;
                    tr_read4(trbase + 16 * s * AT_VPITCH, lo0, hi0, lo1, hi1);
                    const bf16x8 va0 = __builtin_shufflevector(lo0, hi0, 0, 1, 2, 3, 4, 5, 6, 7), va1 = __builtin_shufflevector(lo1, hi1, 0, 1, 2, 3, 4, 5, 6, 7);
                    O0 = MFMA32(va0, pf, O0); O1 = MFMA32(va1, pf, O1);
                }
            }
            const float inv = __builtin_amdgcn_rcpf(den), lse = mx + __builtin_amdgcn_logf(den);
            const int tokidx = qtok - chunk * 512;
            LAS unsigned char* orow = lds + tokidx * AT_OPITCH; const int fsw = (tokidx ^ (tokidx >> 4)) & 15;
            float wo = 0.f, wn = inv, lnew = lse;
            if (g > 0) { const float lold = LSE[tokidx]; const float mxl = fmaxf(lold, lse); lnew = mxl + __builtin_amdgcn_logf(__builtin_amdgcn_exp2f(lold - mxl) + __builtin_amdgcn_exp2f(lse - mxl)); wo = __builtin_amdgcn_exp2f(lold - lnew); wn = __builtin_amdgcn_exp2f(lse - lnew) * inv; }
#pragma unroll
            for (int dt = 0; dt < 2; ++dt)
#pragma unroll
                for (int a4 = 0; a4 < 4; ++a4) {
                    LAS u32x2* p = (LAS u32x2*)(orow + (((dt * 8 + a4 * 2 + h) ^ fsw) << 3));
                    f32x4 v;
#pragma unroll
                    for (int j = 0; j < 4; ++j) v[j] = (dt ? O1[4 * a4 + j] : O0[4 * a4 + j]) * wn;
                    if (g > 0) { const u32x2 ow = *p; v[0] += wo * bflo(ow.x); v[1] += wo * bfhi(ow.x); v[2] += wo * bflo(ow.y); v[3] += wo * bfhi(ow.y); }
                    u32x2 nw; nw.x = pk2(v[0], v[1]); nw.y = pk2(v[2], v[3]); *p = nw;
                }
            if (h == 0) LSE[tokidx] = lnew;
        }
        __syncthreads();
    }
    bf16* mo = MERGED + ((size_t)b * SEQ + chunk * 512) * PMW + 512 + hq * 64;
#pragma unroll
    for (int it = 0; it < 8; ++it) { const int idx = tid + 512 * it, tok = idx >> 3, pc = idx & 7;
        const int fsw = (tok ^ (tok >> 4)) & 15;
        u32x4 w = *(const LAS u32x4*)(lds + tok * AT_OPITCH + ((pc ^ (fsw >> 1)) << 4));
        if (fsw & 1) w = (u32x4){w.z, w.w, w.x, w.y};
        *(u32x4*)(mo + (size_t)tok * PMW + pc * 8) = w; }
    __syncthreads();
}

__device__ __forceinline__ void pool_unit(LAS unsigned char* lds, const bf16* Z, bf16* POOLED, int b, int t0, int wid, int lane, int tid) {
    const bf16* zb = Z + (size_t)b * SEQ * 512;
    { u32x4 rv[10];
#pragma unroll
      for (int k = 0; k < 10; ++k) { int t = t0 - 8 + wid + 8 * k; t = t < 0 ? 0 : (t >= SEQ ? SEQ - 1 : t); rv[k] = *(const u32x4*)(zb + (size_t)t * 512 + lane * 8); }
#pragma unroll
      for (int k = 0; k < 10; ++k) *(LAS u32x4*)(lds + (wid + 8 * k) * 1024 + lane * 16) = rv[k]; }
    __syncthreads();
#pragma unroll 1
    for (int k = 0; k < 8; ++k) { const int gi = (wid + k) & 3, slot = wid * 2 + (k >> 2), tl = slot * 4 + (lane >> 4), cu = gi * 16 + (lane & 15), t = t0 + tl, hw = 1 << gi;
        const int lo = (t - hw) < 0 ? 0 : (t - hw), hi = (t + hw) > SEQ ? SEQ : (t + hw);
        f32x4 s0 = (f32x4){0.f, 0.f, 0.f, 0.f}, s1 = s0;
        for (int j = lo; j < hi; ++j) { const u32x4 w = *(const LAS u32x4*)(lds + (j - t0 + 8) * 1024 + cu * 16); f32x4 a0, a1; ep::unpack8(w, a0, a1); s0 += a0; s1 += a1; }
        const float ic = 1.0f / (float)(hi - lo);
        const u32x4 w = *(const LAS u32x4*)(lds + (tl + 8) * 1024 + cu * 16); f32x4 a0, a1; ep::unpack8(w, a0, a1);
        s0 = s0 * ic - a0; s1 = s1 * ic - a1;
        u32x4 o; o.x = pk2(s0[0], s0[1]); o.y = pk2(s0[2], s0[3]); o.z = pk2(s1[0], s1[1]); o.w = pk2(s1[2], s1[3]);
        *(u32x4*)(POOLED + ((size_t)b * SEQ + t) * PMW + cu * 8) = o; }
    __syncthreads();
}

#define XB_TMO      128
#define XB_XCNT(j)  (256  + 64 * (j))
#define XB_XSUB(j)  (1280 + 64 * (j))
#define XB_XGEN(j)  (2304 + 64 * (j))
#define XB_TOP      3328
#define XB_TOPGEN   3392
#define XCD_BAR_WORDS 3456
#define XB_SPIN_CAP (1u << 18)

__device__ __forceinline__ unsigned xb_ld(unsigned* p)              { return __hip_atomic_load(p, __ATOMIC_RELAXED, __HIP_MEMORY_SCOPE_AGENT); }
__device__ __forceinline__ unsigned xb_add(unsigned* p, unsigned v) { return __hip_atomic_fetch_add(p, v, __ATOMIC_RELAXED, __HIP_MEMORY_SCOPE_AGENT); }
__device__ __forceinline__ unsigned xb_xcc_id() { return (unsigned)__builtin_amdgcn_s_getreg((3 << 11) | 20) & 0xFu; }
#define XB_SPIN(cond, bar) do { unsigned _sp = 0; while (cond) { __builtin_amdgcn_s_sleep(1); \
    if ((++_sp & 255u) == 0u) { if (xb_ld(&(bar)[XB_TMO])) break; if (_sp > XB_SPIN_CAP) { atomicAdd(&(bar)[XB_TMO], 1u); break; } } } } while (0)

struct XcdBarrier {
    unsigned* bar; unsigned x;
    volatile LAS unsigned* st;
};

__device__ __forceinline__ XcdBarrier xcd_barrier_post(unsigned* bar, volatile LAS unsigned* st) {
    XcdBarrier b; b.bar = bar; b.x = xb_xcc_id(); b.st = st;
    if (threadIdx.x == 0) (void)xb_add(&bar[XB_XCNT(b.x)], 1u);
    return b;
}
__device__ __forceinline__ void xcd_barrier_complete(unsigned* bar, unsigned x, unsigned& nloc, unsigned& nx) {
    const unsigned G = gridDim.x * gridDim.y * gridDim.z;
    unsigned sum, cnt, mine, sp = 0u;
    for (;;) {
        sum = 0u; cnt = 0u; mine = 0u;
#pragma unroll
        for (unsigned j = 0; j < 16; ++j) { const unsigned c = xb_ld(&bar[XB_XCNT(j)]); sum += c; cnt += (c > 0u) ? 1u : 0u; mine = (j == x) ? c : mine; }
        if (sum == G) break;
        __builtin_amdgcn_s_sleep(1);
        if ((++sp & 255u) == 0u) { if (xb_ld(&bar[XB_TMO])) break; if (sp > XB_SPIN_CAP) { atomicAdd(&bar[XB_TMO], 1u); break; } }
    }
    nloc = mine > 0u ? mine : 1u; nx = cnt > 0u ? cnt : 1u;
}

__device__ __forceinline__ void xcd_barrier(const XcdBarrier& b) {
    asm volatile("s_waitcnt vmcnt(0)" ::: "memory");
    __syncthreads();
    if (threadIdx.x == 0) {
        unsigned* bar = b.bar;
        __builtin_amdgcn_s_waitcnt(0);
        unsigned nloc = b.st[0], nx = b.st[1];
        if (nloc == 0u) { xcd_barrier_complete(bar, b.x, nloc, nx); b.st[0] = nloc; b.st[1] = nx; }
        const unsigned old = xb_add(&bar[XB_XSUB(b.x)], 1u);
        const unsigned gen = old / nloc;
        if (old + 1u == (gen + 1u) * nloc) {
            __builtin_amdgcn_fence(__ATOMIC_RELEASE, "agent");
            asm volatile("s_waitcnt vmcnt(0)" ::: "memory");
            const unsigned og = xb_add(&bar[XB_TOP], 1u);
            const unsigned tg = og / nx;
            if (og + 1u == (tg + 1u) * nx) xb_add(&bar[XB_TOPGEN], 1u);
            else XB_SPIN(xb_ld(&bar[XB_TOPGEN]) == tg, bar);
            __builtin_amdgcn_fence(__ATOMIC_ACQUIRE, "agent");
            xb_add(&bar[XB_XGEN(b.x)], 1u);
            asm volatile("s_waitcnt vmcnt(0)" ::: "memory");
        } else {
            XB_SPIN(xb_ld(&bar[XB_XGEN(b.x)]) == gen, bar);
            __builtin_amdgcn_fence(__ATOMIC_ACQUIRE, "agent");
            asm volatile("s_waitcnt vmcnt(0)" ::: "memory");
        }
    }
    __syncthreads();
}

struct Args { const float* in[16]; float* out; unsigned char* ws; int ph_lo, ph_hi; };

__global__ void __launch_bounds__(NWAVES * 64, 2) mk_fwd(Args args) {
    extern __shared__ __attribute__((aligned(16))) unsigned char lds_raw[];
    LAS unsigned char* lds = (LAS unsigned char*)lds_raw;
    cg::grid_group grid = cg::this_grid();
    const int tid = threadIdx.x, lane = tid & 63, wid = __builtin_amdgcn_readfirstlane(tid >> 6);
    const int G = gridDim.x, bx = blockIdx.x;
    const int vcu = (G % 8 == 0) ? (bx % 8) * (G / 8) + bx / 8 : bx;
    const __attribute__((address_space(4))) unsigned char* ka = (const __attribute__((address_space(4))) unsigned char*)__builtin_amdgcn_kernarg_segment_ptr();
    typedef const float* cfp_t; typedef unsigned char* ucp_t;
#define ARG_IN(i) (*(volatile cfp_t __attribute__((address_space(4)))*)(ka + 8 * (i)))
#define ARG_OUT() ((float*)*(volatile cfp_t __attribute__((address_space(4)))*)(ka + 128))
#define ARG_WS() (*(volatile ucp_t __attribute__((address_space(4)))*)(ka + 136))
#define WSP(off) ((bf16*)(ws + (off)))
    const int lo = args.ph_lo, hi = args.ph_hi;
    volatile LAS unsigned* xb_st = (volatile LAS unsigned*)(lds + RING_BYTES + 8192);
    if (tid < 2) xb_st[tid] = 0u;
    __syncthreads();
    const unsigned sk8 = (unsigned)((bx >> 3) & 7);
#ifndef PH_MASK
#define PH_MASK 255
#endif
#define IN(k) (((PH_MASK >> (k)) & 1) && lo <= (k) && (k) < hi)
#define SEAM(k) do { if (IN(k) && IN((k) + 1)) { if ((k) == 0) grid.sync(); else { XcdBarrier xb_; xb_.bar = (unsigned*)ARG_WS(); xb_.x = xb_xcc_id(); xb_.st = xb_st; xcd_barrier(xb_); } } } while (0)
#ifndef PROBE_DUP
#define PROBE_DUP -1
#endif
#define REPS(k) for (int rep_ = 0; rep_ < ((PROBE_DUP == (k)) ? 2 : 1); ++rep_)

    REPS(0) if (IN(0)) { if (rep_) grid.sync();
        unsigned char* ws = ARG_WS();
        bf16* W1T = WSP(WS_W1T); bf16* WPT = WSP(WS_WPT); bf16* WOT = WSP(WS_WOT); bf16* WGUT = WSP(WS_WGUT); bf16* WDT = WSP(WS_WDT);
        float* ROPE = (float*)(ws + WS_ROPE); bf16* XB = WSP(WS_XB);
        LAS float* scr = (LAS float*)(lds + wid * 16384);
        const int gw = vcu * NWAVES + wid, NGW = G * NWAVES;
        constexpr int I_IN = (DM / 64) * (ZW / 32), I_G = (DM / 64) * (GW / 32), I_UA = (256 / 64) * (DM / 32), I_O = (DM / 64) * (DM / 32), I_F = (DM / 64) * (FF / 32), I_D = (FF / 64) * (DM / 32);
        constexpr int NITEMS = I_IN + I_G + I_UA + I_O + 2 * I_F + I_D;
        for (int it = gw; it < NITEMS; it += NGW) {
            int r = it;
            if (r < I_IN) { p0_transpose_item(ARG_IN(3), DM, ZW, W1T, 2, 0, ARG_IN(2), scr, r, lane); continue; } r -= I_IN;
            if (r < I_G) { p0_transpose_item(ARG_IN(8), DM, GW, W1T, 3, ZW, ARG_IN(2), scr, r, lane); continue; } r -= I_G;
            if (r < I_UA) { p0_transpose_item(ARG_IN(7), 256, DM, WPT, 3, 0, nullptr, scr, r, lane, PMW, 512); continue; } r -= I_UA;
            if (r < I_O) { p0_transpose_item(ARG_IN(10), DM, DM, WOT, 3, 0, nullptr, scr, r, lane); continue; } r -= I_O;
            if (r < I_F) { p0_transpose_item(ARG_IN(12), DM, FF, WGUT, 1, 0, ARG_IN(11), scr, r, lane); continue; } r -= I_F;
            if (r < I_F) { p0_transpose_item(ARG_IN(13), DM, FF, WGUT, 1, 128, ARG_IN(11), scr, r, lane); continue; } r -= I_F;
            p0_transpose_item(ARG_IN(14), FF, DM, WDT, 3, 0, nullptr, scr, r, lane);
        }
        for (int it = vcu; it < 128; it += G) { const int g = it >> 5, cb = (it >> 1) & 15, n = (it & 1) * 512 + tid;
            const float* maps = ARG_IN(4) + (size_t)(g * 128 + cb * 8) * 128; const float* sc = ARG_IN(5) + g * 128; const float* wu = ARG_IN(6) + (size_t)g * 128 * DM + n;
            float a[8];
#pragma unroll
            for (int ci = 0; ci < 8; ++ci) a[ci] = 0.f;
#pragma unroll 16
            for (int dd = 0; dd < 128; ++dd) { const float w = wu[(size_t)dd * DM] * sc[dd];
#pragma unroll
                for (int ci = 0; ci < 8; ++ci) a[ci] += maps[ci * 128 + dd] * w; }
            u32x4 o; o.x = pk2(a[0], a[1]); o.y = pk2(a[2], a[3]); o.z = pk2(a[4], a[5]); o.w = pk2(a[6], a[7]);
            { const int a_ = n & 255, np = (n & ~255) + 128 * ((a_ >> 5) & 1) + 32 * (a_ >> 6) + (a_ & 31);
              *(u32x4*)(WPT + (size_t)np * PMW + g * 128 + cb * 8) = o; } }
        for (int i = vcu * 512 + tid; i < 384 * 64; i += G * 512) ((unsigned*)(ws + WS_CNT))[i] = 0u;
        for (int i = vcu * 512 + tid; i < 4096; i += G * 512) ((unsigned*)ws)[i] = 0u;
        for (int i = vcu * 512 + tid; i < SEQ * 8; i += G * 512) { const int pos = i >> 3, f = i & 7;
            const float invf = exp2f(-(float)f * (18.931568569324174f / 8.0f));
            const double rev = (double)pos * (double)invf * 0.15915494309189535; const float fr_ = (float)(rev - __builtin_rint(rev));
            const float sn = __builtin_amdgcn_sinf(fr_), cs = __builtin_amdgcn_cosf(fr_);
            ROPE[pos * 16 + f] = cs; ROPE[pos * 16 + 8 + f] = sn; }
        for (int m0 = gw * 4; m0 < T; m0 += NGW * 4) {
            f32x4 v[4][4];
#pragma unroll
            for (int rr = 0; rr < 4; ++rr) { const int m = m0 + rr;
                const float* xrow = (m < 32 * SEQ) ? ARG_IN(0) + (size_t)m * DM : ARG_IN(1) + (size_t)(m - 32 * SEQ) * DM;
                const f32x4* xr = (const f32x4*)xrow + lane;
#pragma unroll
                for (int j = 0; j < 4; ++j) v[rr][j] = xr[64 * j]; }
#pragma unroll
            for (int rr = 0; rr < 4; ++rr) { float s = 0.f;
#pragma unroll
                for (int j = 0; j < 4; ++j) s += (v[rr][j].x * v[rr][j].x + v[rr][j].y * v[rr][j].y) + (v[rr][j].z * v[rr][j].z + v[rr][j].w * v[rr][j].w);
                const float rstd = 1.0f / sqrtf(wave_sum(s) * (1.0f / DM) + EPS);
                u32x2* o8 = (u32x2*)(XB + (size_t)(m0 + rr) * DM) + lane;
#pragma unroll
                for (int j = 0; j < 4; ++j) { u32x2 w; w.x = pk2(v[rr][j].x * rstd, v[rr][j].y * rstd); w.y = pk2(v[rr][j].z * rstd, v[rr][j].w * rstd); o8[64 * j] = w; } }
        }
        __syncthreads();
    }
    SEAM(0);
    if (IN(0) && IN(1)) (void)xcd_barrier_post((unsigned*)ARG_WS(), xb_st);
    REPS(1) if (IN(1)) { if (rep_) grid.sync();
        unsigned char* ws = ARG_WS();
        pg8::Gemm g{WSP(WS_XB), WSP(WS_W1T), T, N1, DM}; pg8::StaticOrder S; S.init(T, N1, G, bx);
        { LAS float* bl = (LAS float*)(lds + RING_BYTES); const float* bg = ARG_IN(9);
          for (int i = tid; i < GW; i += NWAVES * 64) bl[i] = bg[i] * -1.4426950408889634f;
          __syncthreads(); }
        ep::EpiZG E{WSP(WS_Z), (bf16*)ARG_OUT(), (const LAS float*)(lds + RING_BYTES), (const float*)(ws + WS_ROPE)};
        skew_wait((unsigned)SKEW1 * (unsigned)((bx < 128 ? 0 : 4) + ((bx >> 3) & 3)));
        pg8::gemm_phase<ep::EpiZG, pg8::StaticOrder, true, true>(lds, g, S, E);
    }
    SEAM(1);
    REPS(2) if (IN(2)) { if (rep_) grid.sync();
        unsigned char* ws = ARG_WS(); const bf16* Z = WSP(WS_Z); bf16* MERGED = WSP(WS_PM); bf16* POOLED = WSP(WS_PM);
        for (int u = vcu; u < NB * 16; u += G) attn_unit(lds, Z, MERGED, u >> 4, (u >> 2) & 3, u & 3, wid, lane, tid);
        for (int u = vcu; u < NB * 32; u += G) pool_unit(lds, Z, POOLED, u >> 5, (u & 31) * 64, wid, lane, tid);
#if PROBE_DUP == 22
        for (int u = vcu; u < NB * 32; u += G) pool_unit(lds, Z, POOLED, u >> 5, (u & 31) * 64, wid, lane, tid);
#endif
    }
    SEAM(2);
    REPS(3) if (IN(3)) { if (rep_) grid.sync();
        unsigned char* ws = ARG_WS();
        pg8::Gemm g{WSP(WS_PM), WSP(WS_WPT), T, DM, PMW}; pg8::StaticOrder S; S.init(T, DM, G, bx); ep::EpiGateCat E{WSP(WS_Z), (const bf16*)ARG_OUT()};
        pg8::gemm_phase<ep::EpiGateCat, pg8::StaticOrder, true, true>(lds, g, S, E);
    }
    SEAM(3);
    REPS(4) if (IN(4)) { if (rep_) grid.sync();
        unsigned char* ws = ARG_WS();
        pg8::Gemm g{WSP(WS_Z), WSP(WS_WOT), T, DM, DM}; pg8::StaticOrder S; S.init(T, DM, G, bx);
        skew_wait((unsigned)SKEW4 * sk8);
        ep::EpiRes E{ARG_IN(0), ARG_IN(1) - (size_t)32 * SEQ * DM, WSP(WS_XB), (float*)(ws + WS_SSQ2), (LAS float*)(lds + RING_BYTES)};
        pg8::gemm_phase<ep::EpiRes, pg8::StaticOrder, true, true>(lds, g, S, E);
    }
    SEAM(4);
    REPS(5) if (IN(5)) { if (rep_) grid.sync();
        unsigned char* ws = ARG_WS();
        pg8::Gemm g{WSP(WS_XB), WSP(WS_WGUT), T, 2 * FF, DM}; pg8::StaticOrder S; S.init(T, 2 * FF, G, bx);
        skew_wait((unsigned)SKEW5 * sk8);
#if PROBE_DUP == 5
        if (rep_ == 0) { ep::EpiDry E{(float*)(ws + WS_SLOTS)}; pg8::gemm_phase<ep::EpiDry, pg8::StaticOrder, true, true>(lds, g, S, E); } else
#endif
        { ep::EpiSwiGLU E{WSP(WS_Z), (const float*)(ws + WS_SSQ2)};
        pg8::gemm_phase<ep::EpiSwiGLU, pg8::StaticOrder, true, true>(lds, g, S, E); }
    }
    SEAM(5);
    if (IN(6)) {
        unsigned char* ws = ARG_WS();
        pg8::Gemm g{WSP(WS_Z), WSP(WS_WDT), T, DM, FF}; pg8::StaticOrder S; S.init(T, DM, G, bx);
        skew_wait((unsigned)SKEW6 * sk8);
        ep::EpiFinal E{ARG_OUT(), WSP(WS_XB), ARG_IN(15), (unsigned*)(ws + WS_SLOTS), (unsigned*)(ws + WS_CNT), (LAS float*)(lds + RING_BYTES)};
        pg8::gemm_phase<ep::EpiFinal, pg8::StaticOrder, true, true>(lds, g, S, E);
    }
#undef IN
#undef SEAM
}

extern "C" void kernel_launch(void* const* d_in, const int* in_sizes, int n_in, void* d_out, int out_size, void* d_ws, size_t ws_size, hipStream_t stream) {
    static int grid = 0;
    if (grid == 0) {
        if (n_in != 16 || in_sizes[0] != 32 * SEQ * DM || in_sizes[1] != 16 * SEQ * DM || out_size != T * DM || ws_size < WS_END) {
            fprintf(stderr, "kernel_launch: unexpected shapes (n_in %d out %d ws %zu)\n", n_in, out_size, ws_size); grid = -1; return; }
        int dev = 0, cus = 0, per_cu = 0;
        hipGetDevice(&dev); hipDeviceGetAttribute(&cus, hipDeviceAttributeMultiprocessorCount, dev);
        hipFuncSetAttribute((const void*)mk_fwd, hipFuncAttributeMaxDynamicSharedMemorySize, LDS_BYTES);
        hipOccupancyMaxActiveBlocksPerMultiprocessor(&per_cu, (const void*)mk_fwd, NWAVES * 64, LDS_BYTES);
        (void)hipGetLastError();
        if (per_cu < 1) per_cu = 1;
        grid = cus * 1;
    }
    if (grid < 0) return;
    Args a{};
    for (int i = 0; i < 16; ++i) a.in[i] = (const float*)d_in[i];
    a.out = (float*)d_out; a.ws = (unsigned char*)d_ws;
#if MK_ONE_LAUNCH
    a.ph_lo = 0; a.ph_hi = 7;
    void* kargs[] = {&a};
    hipError_t e = hipLaunchCooperativeKernel((const void*)mk_fwd, dim3(grid), dim3(NWAVES * 64), kargs, LDS_BYTES, stream);
    if (e != hipSuccess) fprintf(stderr, "cooperative launch failed: %s (grid %d)\n", hipGetErrorString(e), grid);
#else
    for (int p = 0; p < 7; ++p) { a.ph_lo = p; a.ph_hi = p + 1; hipLaunchKernelGGL(mk_fwd, dim3(grid), dim3(NWAVES * 64), LDS_BYTES, stream, a); }
#endif
}
```

```cpp
#include <hip/hip_runtime.h>
#include <cstdio>
#include <cstdint>
namespace pg8 {
#define PG8_LAS __attribute__((address_space(3)))
typedef unsigned short bf16_t;
typedef short bf16x8 __attribute__((ext_vector_type(8)));
typedef float f32x4 __attribute__((ext_vector_type(4)));
typedef unsigned u32x4 __attribute__((ext_vector_type(4)));
constexpr int BM = 256, BK = 64, HALF = 128, HTB = HALF * BK * 2  , STAGE_BYTES = 8 * HTB, NXCD = 8, WGM = 8;

__host__ __device__ __forceinline__ int lds_byte(int r, int c) { const int st = (r >> 4) * 2 + (c >> 5), rr = r & 15, cc = c & 31, ob = rr * 64 + cc * 2; return st * 1024 + (ob ^ (((ob >> 9) & 1) << 5)); }
__host__ __device__ __forceinline__ void stage_rc(int b, int& R, int& C) { const int st = b / 1024, sb = b % 1024, swz = sb ^ (((sb >> 9) & 1) << 5); R = (st >> 1) * 16 + swz / 64; C = (st & 1) * 32 + (swz % 64) / 2; }
__host__ __device__ __forceinline__ int perm32(int rho) { const int n = rho >> 4, i = rho & 15; return 8 * (i >> 2) + 4 * n + (i & 3); }

struct Unit { int pm, pn; };
struct Gemm { const bf16_t* A; const bf16_t* Bt; int M, N, K; };

struct StaticOrder {
    int nM, nN, nwg, G, c;
    __host__ __device__ void init(int M, int N, int G_, int c_) { nM = M / BM; nN = N / BM; nwg = nM * nN; G = G_; c = c_; }
    __host__ __device__ bool next(int i, Unit& u) const {
        const long L = (long)i * G + c; if (L >= nwg) return false;
        int wgid = (int)L; { const int q = nwg / NXCD, r = nwg % NXCD, xcd = wgid % NXCD, off = wgid / NXCD; wgid = (xcd < r ? xcd * (q + 1) : r * (q + 1) + (xcd - r) * q) + off; }
        const int nig = WGM * nN, gid = wgid / nig, fm = gid * WGM, gsz = (nM - fm) < WGM ? (nM - fm) : WGM;
        u.pm = fm + ((wgid % nig) % gsz); u.pn = (wgid % nig) / gsz; return true;
    }
    __device__ __forceinline__ void a_ready(const Unit&) const {}
    __device__ __forceinline__ void done(const Unit&) const {}
};

__device__ __forceinline__ unsigned cvt_pk_bf16(float lo, float hi) { unsigned r; asm volatile("v_cvt_pk_bf16_f32 %0, %1, %2" : "=v"(r) : "v"(lo), "v"(hi)); return r; }
typedef float f32x2 __attribute__((ext_vector_type(2)));
__device__ __forceinline__ f32x2 gelu_pk(f32x2 v) {
    const f32x2 av = __builtin_elementwise_abs(v), d = av * 0.2316418882f + 1.0f;
    f32x2 t; t.x = __builtin_amdgcn_rcpf(d.x); t.y = __builtin_amdgcn_rcpf(d.y);
    f32x2 q = t * 0.5307027145f + (-0.7265760135f); q = q * t + 0.7107068705f; q = q * t + (-0.142248368f); q = q * t + 0.127414796f; q = q * t;
    const f32x2 s = (v * v) * (-0.72134752044f);
    f32x2 e; e.x = __builtin_amdgcn_exp2f(s.x); e.y = __builtin_amdgcn_exp2f(s.y);
    const f32x2 m = v * (q * e), r = v - m;
    f32x2 o; o.x = v.x < 0.f ? m.x : r.x; o.y = v.y < 0.f ? m.y : r.y; return o;
}

template <int ACT  > struct EpiBf16 {
    static constexpr bool PERM = true, AFTER_DRAIN = false; static_assert(ACT == 0 || ACT == 1, "EpiBf16: ACT is 0 (none) or 1 (gelu_pk)");
    bf16_t* O; int ldc; const float* bias; int split_cols; size_t split_stride; float scale0;
    __device__ __forceinline__ void operator()(const f32x4 (&acc)[2][2][4][2], const Unit& u, int wr, int wc, int fr, int fq) const {
        const int row0 = u.pm * BM + wr * 64 + fr; int colt = u.pn * BM; bf16_t* base = O;
        float sc = 1.f; if (split_cols) { const int t = colt / split_cols; base += (size_t)t * split_stride; colt -= t * split_cols; if (t == 0) sc = scale0; }
        const int col0 = colt + wc * 32 + 8 * fq, bcol0 = u.pn * BM + wc * 32 + 8 * fq;
        f32x4 bv[2][2];
#pragma unroll
        for (int bj = 0; bj < 2; ++bj)
#pragma unroll
            for (int n = 0; n < 2; ++n) bv[bj][n] = bias ? *(const f32x4*)(bias + bcol0 + bj * HALF + 4 * n) : (f32x4){0.f, 0.f, 0.f, 0.f};
#pragma unroll
        for (int ai = 0; ai < 2; ++ai)
#pragma unroll
            for (int m = 0; m < 4; ++m) { bf16_t* rowp = base + (size_t)(row0 + ai * HALF + m * 16) * ldc + col0;
#pragma unroll
                for (int bj = 0; bj < 2; ++bj) { f32x4 v0 = acc[ai][bj][m][0] + bv[bj][0], v1 = acc[ai][bj][m][1] + bv[bj][1];
                    if (ACT == 1) { f32x2 a = gelu_pk((f32x2){v0[0], v0[1]}), b = gelu_pk((f32x2){v0[2], v0[3]}), c = gelu_pk((f32x2){v1[0], v1[1]}), d = gelu_pk((f32x2){v1[2], v1[3]});
                        v0 = (f32x4){a.x, a.y, b.x, b.y}; v1 = (f32x4){c.x, c.y, d.x, d.y}; }
                    v0 = v0 * sc; v1 = v1 * sc; u32x4 w; w.x = cvt_pk_bf16(v0[0], v0[1]); w.y = cvt_pk_bf16(v0[2], v0[3]); w.z = cvt_pk_bf16(v1[0], v1[1]); w.w = cvt_pk_bf16(v1[2], v1[3]);
                    *(u32x4*)(rowp + bj * HALF) = w; } }
    }
};
template <class Epi, class Sched, bool ALIGN_EPI = false, bool SP2 = false>
__device__ __forceinline__ void gemm_phase(PG8_LAS unsigned char* lds, const Gemm g, const Sched& S, const Epi& E) {
    const int tid = threadIdx.x, wid = __builtin_amdgcn_readfirstlane(tid >> 6), lane = tid & 63, wr = wid >> 2, wc = wid & 3, fr = lane & 15, fq = lane >> 4;
    const int K = g.K, nt = K / BK;
    unsigned voffA[2], voffB[2];
#pragma unroll
    for (int i = 0; i < 2; ++i) { int R, C; stage_rc(tid * 16 + i * 8192, R, C); const int Rb = Epi::PERM ? ((R & ~31) + perm32(R & 31)) : R;
        voffA[i] = (unsigned)(R * K + C) * 2u; voffB[i] = (unsigned)(Rb * K + C) * 2u; }
    const size_t kstep = (size_t)(BK * 2);
    const size_t hstep = (size_t)HALF * K * 2;
    const size_t tstep = 2 * hstep;
    const unsigned ldsw = (unsigned)wid * 1024u;
    const int aoff = lds_byte(wr * 64 + fr, fq * 8), boff = lds_byte(wc * 32 + fr, fq * 8);
#define PG8_SA(b, h) (((b) * 2 + (h)) * HTB)
#define PG8_SB(b, h) ((4 + (b) * 2 + (h)) * HTB)
#define PG8_STAGE(bufoff, gbase, voff) do { _Pragma("unroll") for (int _i = 0; _i < 2; ++_i) \
        __builtin_amdgcn_global_load_lds((const unsigned*)((const char*)(gbase) + (voff)[_i]), (PG8_LAS unsigned*)(lds + (bufoff) + ldsw + _i * 8192), 16, 0, 0); } while (0)
#define PG8_LDA(dst, b, h) do { _Pragma("unroll") for (int m = 0; m < 4; ++m) _Pragma("unroll") for (int k = 0; k < 2; ++k) dst[m][k] = *(const PG8_LAS bf16x8*)(lds + PG8_SA(b, h) + aoff + m * 2048 + k * 1024); } while (0)
#define PG8_LDB(dst, b, h) do { _Pragma("unroll") for (int n = 0; n < 2; ++n) _Pragma("unroll") for (int k = 0; k < 2; ++k) dst[n][k] = *(const PG8_LAS bf16x8*)(lds + PG8_SB(b, h) + boff + n * 2048 + k * 1024); } while (0)
#define PG8_MMA(ai, bj, At, Bt) do { __builtin_amdgcn_s_setprio(1); _Pragma("unroll") for (int m = 0; m < 4; ++m) _Pragma("unroll") for (int n = 0; n < 2; ++n) _Pragma("unroll") for (int k = 0; k < 2; ++k) \
        acc[ai][bj][m][n] = __builtin_amdgcn_mfma_f32_16x16x32_bf16(Bt[n][k], At[m][k], acc[ai][bj][m][n], 0, 0, 0); __builtin_amdgcn_s_setprio(0); } while (0)
#define PG8_WAIT_V(n) asm volatile("s_waitcnt vmcnt(" #n ")" ::: "memory")
#define PG8_WAIT_L(n) asm volatile("s_waitcnt lgkmcnt(" #n ")" ::: "memory")
#define PG8_BAR __builtin_amdgcn_s_barrier()
#define PG8_SCHED __builtin_amdgcn_sched_barrier(0)
    Unit cur, nxt; int ui = 0;
    if (!S.next(0, cur)) return;
    f32x4 acc[2][2][4][2];
    if constexpr (Epi::INIT) E.init(acc, cur, wr, wc, fr, fq); else {
#pragma unroll
    for (int a = 0; a < 2; ++a)
#pragma unroll
        for (int b = 0; b < 2; ++b)
#pragma unroll
            for (int m = 0; m < 4; ++m)
#pragma unroll
                for (int n = 0; n < 2; ++n) acc[a][b][m][n] = (f32x4){0.f, 0.f, 0.f, 0.f};
    }
    bf16x8 At[4][2], B0[2][2], B1[2][2];
    const char* cA = (const char*)g.A + (size_t)cur.pm * tstep; const char* cB = (const char*)g.Bt + (size_t)cur.pn * tstep;
    S.a_ready(cur);
    if constexpr (SP2) {
        PG8_STAGE(PG8_SB(0, 0), cB, voffB); PG8_STAGE(PG8_SB(0, 1), cB + hstep, voffB); PG8_STAGE(PG8_SA(0, 0), cA, voffA); PG8_STAGE(PG8_SA(0, 1), cA + hstep, voffA);
        if (wr == 1) PG8_BAR;
        PG8_WAIT_V(2); PG8_BAR;
        PG8_STAGE(PG8_SB(1, 0), cB + kstep, voffB); PG8_STAGE(PG8_SA(1, 0), cA + kstep, voffA); PG8_STAGE(PG8_SB(1, 1), cB + hstep + kstep, voffB);
        PG8_WAIT_V(6); PG8_BAR;
    } else {
        PG8_STAGE(PG8_SB(0, 0), cB, voffB); PG8_STAGE(PG8_SA(0, 0), cA, voffA); PG8_STAGE(PG8_SB(0, 1), cB + hstep, voffB); PG8_STAGE(PG8_SA(0, 1), cA + hstep, voffA);
        if (wr == 1) PG8_BAR;
        PG8_WAIT_V(4); PG8_BAR;
        PG8_STAGE(PG8_SB(1, 0), cB + kstep, voffB); PG8_STAGE(PG8_SA(1, 0), cA + kstep, voffA); PG8_STAGE(PG8_SB(1, 1), cB + hstep + kstep, voffB);
        PG8_WAIT_V(6); PG8_BAR;
    }
    for (;;) {
        const bool has_next = S.next(ui + 1, nxt);
        const char* nA = has_next ? (const char*)g.A + (size_t)nxt.pm * tstep : cA; const char* nB = has_next ? (const char*)g.Bt + (size_t)nxt.pn * tstep : cB;
_Pragma("unroll 1")
        for (int t = 0; t < nt; t += 2) {
            if constexpr (Epi::MIDK > 0) { if (t == Epi::MIDK) E.mid(acc, cur, wr, wc, fr, fq); }
            const bool last = (t == nt - 2);
            const char* a1 = cA + (size_t)(t + 1) * kstep;
            const char* a2 = last ? nA : cA + (size_t)(t + 2) * kstep; const char* b2 = last ? nB : cB + (size_t)(t + 2) * kstep;
            const char* a3 = a2 + kstep; const char* b3 = b2 + kstep;
            if (last && has_next) S.a_ready(nxt);
            if constexpr (SP2) {
            PG8_LDB(B0, 0, 0); PG8_LDB(B1, 0, 1); PG8_SCHED; PG8_LDA(At, 0, 0); PG8_STAGE(PG8_SA(1, 1), a1 + hstep, voffA);
            PG8_WAIT_V(8); PG8_WAIT_L(0); PG8_BAR; PG8_MMA(0, 0, At, B0); PG8_MMA(0, 1, At, B1); PG8_BAR; PG8_SCHED;
            PG8_LDA(At, 0, 1); PG8_STAGE(PG8_SB(0, 0), b2, voffB); PG8_STAGE(PG8_SB(0, 1), b2 + hstep, voffB); PG8_STAGE(PG8_SA(0, 0), a2, voffA);
            PG8_WAIT_V(8); PG8_WAIT_L(0); PG8_BAR; PG8_MMA(1, 0, At, B0); PG8_MMA(1, 1, At, B1); PG8_BAR; PG8_SCHED;
            PG8_LDB(B0, 1, 0); PG8_LDB(B1, 1, 1); PG8_SCHED; PG8_LDA(At, 1, 0); PG8_STAGE(PG8_SA(0, 1), a2 + hstep, voffA);
            PG8_WAIT_V(8); PG8_WAIT_L(0); PG8_BAR; PG8_MMA(0, 0, At, B0); PG8_MMA(0, 1, At, B1); PG8_BAR; PG8_SCHED;
            PG8_LDA(At, 1, 1); PG8_STAGE(PG8_SB(1, 0), b3, voffB); PG8_STAGE(PG8_SB(1, 1), b3 + hstep, voffB); PG8_STAGE(PG8_SA(1, 0), a3, voffA);
            PG8_WAIT_V(8); PG8_WAIT_L(0); PG8_BAR; PG8_MMA(1, 0, At, B0); PG8_MMA(1, 1, At, B1); PG8_BAR; PG8_SCHED;
            } else {
            PG8_LDB(B0, 0, 0); PG8_SCHED; PG8_LDA(At, 0, 0); PG8_STAGE(PG8_SA(1, 1), a1 + hstep, voffA);
            PG8_WAIT_L(8); PG8_BAR; PG8_WAIT_L(0); PG8_MMA(0, 0, At, B0); PG8_BAR; PG8_SCHED;
            PG8_LDB(B1, 0, 1); PG8_STAGE(PG8_SB(0, 0), b2, voffB);
            PG8_BAR; PG8_WAIT_L(0); PG8_MMA(0, 1, At, B1); PG8_BAR;
            PG8_LDA(At, 0, 1); PG8_STAGE(PG8_SA(0, 0), a2, voffA);
            PG8_BAR; PG8_WAIT_L(0); PG8_MMA(1, 0, At, B0); PG8_BAR; PG8_SCHED;
            PG8_STAGE(PG8_SB(0, 1), b2 + hstep, voffB);
            PG8_WAIT_V(6); PG8_BAR; PG8_MMA(1, 1, At, B1); PG8_BAR;
            PG8_LDB(B0, 1, 0); PG8_SCHED; PG8_LDA(At, 1, 0); PG8_STAGE(PG8_SA(0, 1), a2 + hstep, voffA);
            PG8_WAIT_L(8); PG8_BAR; PG8_WAIT_L(0); PG8_MMA(0, 0, At, B0); PG8_BAR; PG8_SCHED;
            PG8_LDB(B1, 1, 1); PG8_STAGE(PG8_SB(1, 0), b3, voffB);
            PG8_BAR; PG8_WAIT_L(0); PG8_MMA(0, 1, At, B1); PG8_BAR;
            PG8_LDA(At, 1, 1); PG8_STAGE(PG8_SA(1, 0), a3, voffA);
            PG8_BAR; PG8_WAIT_L(0); PG8_MMA(1, 0, At, B0); PG8_BAR; PG8_SCHED;
            PG8_STAGE(PG8_SB(1, 1), b3 + hstep, voffB);
            PG8_WAIT_V(6); PG8_BAR; PG8_MMA(1, 1, At, B1); PG8_BAR;
            }
        }
        if constexpr (ALIGN_EPI) { if (wr == 0) PG8_BAR; }
        if constexpr (!Epi::AFTER_DRAIN) { E(acc, cur, wr, wc, fr, fq); S.done(cur); }
        if (!has_next) break;
        if constexpr (Epi::INIT) E.init(acc, nxt, wr, wc, fr, fq); else {
#pragma unroll
        for (int a = 0; a < 2; ++a)
#pragma unroll
            for (int b = 0; b < 2; ++b)
#pragma unroll
                for (int m = 0; m < 4; ++m)
#pragma unroll
                    for (int n = 0; n < 2; ++n) acc[a][b][m][n] = (f32x4){0.f, 0.f, 0.f, 0.f};
        }
        cur = nxt; cA = nA; cB = nB; ++ui;
        if constexpr (ALIGN_EPI) { if (wr == 1) PG8_BAR; }
    }
    PG8_WAIT_V(0);
    if constexpr (!ALIGN_EPI) { if (wr == 0) PG8_BAR; }
    PG8_BAR;
    if constexpr (Epi::AFTER_DRAIN) { E.fused(acc, cur, wr, wc, fr, fq, lds, wid, lane); S.done(cur); }
#undef PG8_SA
#undef PG8_SB
#undef PG8_STAGE
#undef PG8_LDA
#undef PG8_LDB
#undef PG8_MMA
#undef PG8_WAIT_V
#undef PG8_WAIT_L
#undef PG8_BAR
#undef PG8_SCHED
}
}

#include <hip/hip_cooperative_groups.h>
namespace cg = cooperative_groups;

#ifndef SKEW1
#define SKEW1 0
#define SKEW3 0
#define SKEW4 0
#define SKEW5 0
#define SKEW6 0
#endif
#ifndef MK_ONE_LAUNCH
#define MK_ONE_LAUNCH 1
#endif

#define LAS __attribute__((address_space(3)))
typedef unsigned short bf16;
typedef float f32x4 __attribute__((ext_vector_type(4)));
typedef float f32x16 __attribute__((ext_vector_type(16)));
typedef unsigned u32x4 __attribute__((ext_vector_type(4)));
typedef unsigned u32x2 __attribute__((ext_vector_type(2)));
typedef short bf16x8 __attribute__((ext_vector_type(8)));
typedef short s16x4 __attribute__((ext_vector_type(4)));

constexpr int NWAVES = 8;
constexpr int SEQ = 2048, DM = 1024, NB = 48, T = NB * SEQ;
constexpr int ZW = 2816, GW = 2048, FF = 2816;
constexpr int N1 = ZW + GW;
constexpr float EPS = 1e-6f;
constexpr int LDS_BYTES = 147456, RING_BYTES = 131072;

constexpr size_t MiB = 1u << 20;
constexpr size_t WS_W1T = 1 * MiB, WS_WPT = 11 * MiB, WS_WUAT = 12 * MiB, WS_WOT = 13 * MiB, WS_WGUT = 15 * MiB, WS_WDT = 26 * MiB;
constexpr size_t WS_ROPE = 32 * MiB, WS_SSQ2 = 34 * MiB, WS_SLOTS = 40 * MiB, WS_CNT = 44 * MiB;
constexpr size_t WS_XB = 48 * MiB;
constexpr size_t WS_PM = WS_XB;
constexpr int PMW = 768;
constexpr size_t WS_Z = 240 * MiB;
constexpr size_t WS_END = 768 * MiB;

__device__ __forceinline__ unsigned f2bf(float f) { unsigned u = __builtin_bit_cast(unsigned, f); return (u + 0x7fffu + ((u >> 16) & 1u)) >> 16; }
typedef __bf16 bf16x2_g __attribute__((ext_vector_type(2))); typedef float f32x2_g __attribute__((ext_vector_type(2)));
__device__ __forceinline__ unsigned pk2(float lo, float hi) { const f32x2_g v = {lo, hi}; return __builtin_bit_cast(unsigned, __builtin_convertvector(v, bf16x2_g)); }
__device__ __forceinline__ float bflo(unsigned w) { return __builtin_bit_cast(float, w << 16); }
__device__ __forceinline__ float bfhi(unsigned w) { return __builtin_bit_cast(float, w & 0xffff0000u); }
__device__ __forceinline__ float wave_sum(float v) {
#pragma unroll
    for (int o = 1; o < 64; o <<= 1) v += __shfl_xor(v, o);
    return v;
}
__device__ __forceinline__ float sigmoidf_(float x) { return __builtin_amdgcn_rcpf(1.0f + __builtin_amdgcn_exp2f(x * -1.4426950408889634f)); }
__device__ __forceinline__ void skew_wait(unsigned ticks) { if (ticks) { const unsigned long long t0 = __builtin_amdgcn_s_memrealtime(); while (__builtin_amdgcn_s_memrealtime() - t0 < ticks) __builtin_amdgcn_s_sleep(4); } }

namespace ep {
using pg8::Unit; using pg8::cvt_pk_bf16;
constexpr int BM = 256, HALF = 128;

typedef __bf16 bf16x2_t __attribute__((ext_vector_type(2)));
typedef float f32x2_t __attribute__((ext_vector_type(2)));
__device__ __forceinline__ unsigned cvt2(float a, float b) { const f32x2_t v = {a, b}; return __builtin_bit_cast(unsigned, __builtin_convertvector(v, bf16x2_t)); }
__device__ __forceinline__ u32x4 pack8(const f32x4 v0, const f32x4 v1) {
    u32x4 w; w.x = cvt2(v0[0], v0[1]); w.y = cvt2(v0[2], v0[3]); w.z = cvt2(v1[0], v1[1]); w.w = cvt2(v1[2], v1[3]); return w;
}
__device__ __forceinline__ void unpack8(const u32x4 w, f32x4& v0, f32x4& v1) {
    v0 = (f32x4){bflo(w.x), bfhi(w.x), bflo(w.y), bfhi(w.y)}; v1 = (f32x4){bflo(w.z), bfhi(w.z), bflo(w.w), bfhi(w.w)};
}

struct EpiZG {
    static constexpr bool PERM = true, AFTER_DRAIN = false, INIT = false; static constexpr int MIDK = 0;
    bf16* Z; bf16* G; const LAS float* bias; const float* rope;
    __device__ __forceinline__ bf16* zptr(int pn, int bj, int wc, int fq, int row) const {
        if (pn < 2) return Z + (size_t)row * 512 + pn * BM + wc * 64 + bj * 32 + 8 * fq;
        const int hidx = (pn - 2) * 4 + wc, sh = 2 * ((hidx % 12) >> 2), tok = row & (SEQ - 1);
        const int pos = ((tok & ((1 << sh) - 1)) << (11 - sh)) | (tok >> sh);
        return Z + (size_t)T * 512 + ((size_t)((((row >> 11) * 36 + hidx) << 11) + pos) << 6) + bj * 32 + 8 * fq;
    }
    __device__ __forceinline__ void operator()(const f32x4 (&acc)[2][2][4][2], const Unit& u, int wr, int wc, int fr_in, int fq_in) const {
        int fr = fr_in, fq = fq_in; asm volatile("" : "+v"(fr), "+v"(fq));
        const int row0 = u.pm * BM + wr * 64 + fr;
        const int cl = wc * 64 + 8 * fq;
        if (u.pn >= 11) {
            const int gc0 = (u.pn - 11) * BM + cl;
            f32x4 bv[2][2];
#pragma unroll
            for (int bj = 0; bj < 2; ++bj)
#pragma unroll
                for (int n = 0; n < 2; ++n) bv[bj][n] = *(const LAS f32x4*)(bias + gc0 + bj * 32 + 4 * n);
#pragma unroll
            for (int ai = 0; ai < 2; ++ai)
#pragma unroll
                for (int m = 0; m < 4; ++m) { bf16* rowp = G + (size_t)(row0 + ai * HALF + m * 16) * GW + gc0;
#pragma unroll
                    for (int bj = 0; bj < 2; ++bj) { f32x4 v0 = acc[ai][bj][m][0] * -1.4426950408889634f + bv[bj][0], v1 = acc[ai][bj][m][1] * -1.4426950408889634f + bv[bj][1];
#pragma unroll
                        for (int j = 0; j < 4; ++j) { v0[j] = __builtin_amdgcn_rcpf(1.0f + __builtin_amdgcn_exp2f(v0[j])); v1[j] = __builtin_amdgcn_rcpf(1.0f + __builtin_amdgcn_exp2f(v1[j])); }
                        *(u32x4*)(rowp + bj * 32) = pack8(v0, v1); }
                    asm volatile("" ::: "memory"); }
        } else {
            const bool rope_tile = (u.pn >= 2 && u.pn < 8);
            const float sc = (u.pn >= 2 && u.pn < 5) ? 0.18033688011112042f : 1.0f;
            if (rope_tile) {
                const float sgn = (fq == 0) ? -1.0f : 1.0f; const bool act = fq < 2;
#pragma unroll
                for (int am = 0; am < 4; ++am) { const int ai = am >> 1;
                    f32x4 tb[2][4];
#pragma unroll
                    for (int mm = 0; mm < 2; ++mm) { const int m = (am & 1) * 2 + mm; const int row = row0 + ai * HALF + m * 16; const f32x4* tp = (const f32x4*)(rope + (row & (SEQ - 1)) * 16);
#pragma unroll
                        for (int k = 0; k < 4; ++k) tb[mm][k] = tp[k]; }
#pragma unroll
                    for (int mm = 0; mm < 2; ++mm) { const int m = (am & 1) * 2 + mm; const int row = row0 + ai * HALF + m * 16;
                        const f32x4 c0 = tb[mm][0], c1 = tb[mm][1], s0 = tb[mm][2] * sgn, s1 = tb[mm][3] * sgn;
                        f32x4 v0 = acc[ai][0][m][0], v1 = acc[ai][0][m][1], p0, p1;
#pragma unroll
                        for (int j = 0; j < 4; ++j) { p0[j] = __shfl_xor(v0[j], 16); p1[j] = __shfl_xor(v1[j], 16); }
                        if (act) { v0 = v0 * c0 + p0 * s0; v1 = v1 * c1 + p1 * s1; }
                        *(u32x4*)zptr(u.pn, 0, wc, fq, row) = pack8(v0 * sc, v1 * sc);
                        *(u32x4*)zptr(u.pn, 1, wc, fq, row) = pack8(acc[ai][1][m][0] * sc, acc[ai][1][m][1] * sc); }
                    asm volatile("" ::: "memory"); }
            } else {
#pragma unroll
                for (int ai = 0; ai < 2; ++ai)
#pragma unroll
                    for (int m = 0; m < 4; ++m) { const int row = row0 + ai * HALF + m * 16;
#pragma unroll
                        for (int bj = 0; bj < 2; ++bj) *(u32x4*)zptr(u.pn, bj, wc, fq, row) = pack8(acc[ai][bj][m][0] * sc, acc[ai][bj][m][1] * sc); }
            }
        }
    }
};

struct EpiGateCat {
    static constexpr bool PERM = true, AFTER_DRAIN = false, INIT = false; static constexpr int MIDK = 8;
    bf16* MB; const bf16* G;
    __device__ __forceinline__ void mid(f32x4 (&acc)[2][2][4][2], const Unit& u, int wr, int wc, int fr_in, int fq_in) const {
        int fr = fr_in, fq = fq_in; asm volatile("" : "+v"(fr), "+v"(fq));
        const int row0 = u.pm * BM + wr * 64 + fr, col0 = u.pn * BM + wc * 64 + 8 * fq;
#pragma unroll
        for (int ai = 0; ai < 2; ++ai) {
            u32x4 ga[4][2], gb[4][2];
#pragma unroll
            for (int m = 0; m < 4; ++m) { const bf16* gp = G + (size_t)(row0 + ai * HALF + m * 16) * GW + col0;
#pragma unroll
                for (int bj = 0; bj < 2; ++bj) { ga[m][bj] = *(const u32x4*)(gp + bj * 32); gb[m][bj] = *(const u32x4*)(gp + DM + bj * 32); } }
#pragma unroll
            for (int m = 0; m < 4; ++m)
#pragma unroll
                for (int bj = 0; bj < 2; ++bj) { f32x4 a0, a1, b0, b1; unpack8(ga[m][bj], a0, a1); unpack8(gb[m][bj], b0, b1);
#pragma unroll
                    for (int j = 0; j < 4; ++j) { a0[j] *= __builtin_amdgcn_rcpf(fmaxf(b0[j], 1e-30f)); a1[j] *= __builtin_amdgcn_rcpf(fmaxf(b1[j], 1e-30f)); }
                    acc[ai][bj][m][0] *= a0; acc[ai][bj][m][1] *= a1; }
            asm volatile("" ::: "memory"); }
    }
    __device__ __forceinline__ void operator()(const f32x4 (&acc)[2][2][4][2], const Unit& u, int wr, int wc, int fr_in, int fq_in) const {
        int fr = fr_in, fq = fq_in; asm volatile("" : "+v"(fr), "+v"(fq));
        const int row0 = u.pm * BM + wr * 64 + fr, col0 = u.pn * BM + wc * 64 + 8 * fq;
        u32x4 gb[2][4][2];
#pragma unroll
        for (int ai = 0; ai < 2; ++ai)
#pragma unroll
            for (int m = 0; m < 4; ++m)
#pragma unroll
                for (int bj = 0; bj < 2; ++bj) gb[ai][m][bj] = *(const u32x4*)(G + (size_t)(row0 + ai * HALF + m * 16) * GW + DM + col0 + bj * 32);
#pragma unroll
        for (int ai = 0; ai < 2; ++ai)
#pragma unroll
            for (int m = 0; m < 4; ++m)
#pragma unroll
                for (int bj = 0; bj < 2; ++bj) { f32x4 b0, b1; unpack8(gb[ai][m][bj], b0, b1);
                    *(u32x4*)(MB + (size_t)(row0 + ai * HALF + m * 16) * DM + col0 + bj * 32) = pack8(acc[ai][bj][m][0] * b0, acc[ai][bj][m][1] * b1); }
    }
};

struct EpiRes {
    static constexpr bool PERM = true, AFTER_DRAIN = false, INIT = true; static constexpr int MIDK = 0;
    const float* base_lo; const float* base_hi; bf16* XB_; float* ssq; LAS float* red;
    __device__ __forceinline__ void init(f32x4 (&acc)[2][2][4][2], const Unit& u, int wr, int wc, int fr_in, int fq_in) const {
        int fr = fr_in, fq = fq_in; asm volatile("" : "+v"(fr), "+v"(fq));
        const int row0 = u.pm * BM + wr * 64 + fr, col0 = u.pn * BM + wc * 64 + 8 * fq;
        const float* base = (u.pm < 256) ? base_lo : base_hi;
#pragma unroll
        for (int ai = 0; ai < 2; ++ai)
#pragma unroll
            for (int m = 0; m < 4; ++m)
#pragma unroll
                for (int bj = 0; bj < 2; ++bj) { const size_t off = (size_t)(row0 + ai * HALF + m * 16) * DM + col0 + bj * 32;
                    acc[ai][bj][m][0] = *(const f32x4*)(base + off); acc[ai][bj][m][1] = *(const f32x4*)(base + off + 4); }
    }
    __device__ __forceinline__ void operator()(const f32x4 (&acc)[2][2][4][2], const Unit& u, int wr, int wc, int fr_in, int fq_in) const {
        int fr = fr_in, fq = fq_in; asm volatile("" : "+v"(fr), "+v"(fq));
        const int row0 = u.pm * BM + wr * 64 + fr, col0 = u.pn * BM + wc * 64 + 8 * fq;
#pragma unroll
        for (int ai = 0; ai < 2; ++ai)
#pragma unroll
            for (int m = 0; m < 4; ++m) { const size_t row = (size_t)(row0 + ai * HALF + m * 16); float q = 0.f;
#pragma unroll
                for (int bj = 0; bj < 2; ++bj) { const size_t off = row * DM + col0 + bj * 32;
                    const f32x4 v0 = acc[ai][bj][m][0], v1 = acc[ai][bj][m][1];
                    *(u32x4*)(XB_ + off) = pack8(v0, v1);
                    q += (v0[0] * v0[0] + v0[1] * v0[1]) + (v0[2] * v0[2] + v0[3] * v0[3]) + (v1[0] * v1[0] + v1[1] * v1[1]) + (v1[2] * v1[2] + v1[3] * v1[3]); }
                q += __shfl_xor(q, 16); q += __shfl_xor(q, 32); if (fq == 0) red[wc * 256 + ai * HALF + wr * 64 + m * 16 + fr] = q; }
        asm volatile("s_waitcnt lgkmcnt(0)" ::: "memory"); __builtin_amdgcn_s_barrier(); asm volatile("" ::: "memory");
        const int t = threadIdx.x;
        if (t < 256) ssq[(size_t)(u.pm * BM + t) * 4 + u.pn] = (red[t] + red[256 + t]) + (red[512 + t] + red[768 + t]);
    }
};

struct EpiFinal {
    static constexpr bool PERM = true, AFTER_DRAIN = false, INIT = true; static constexpr int MIDK = 0;
    float* out; const bf16* X1; const float* gfin; unsigned* slots; unsigned* cnt; LAS float* red;
    __device__ __forceinline__ void init(f32x4 (&acc)[2][2][4][2], const Unit& u, int wr, int wc, int fr_in, int fq_in) const {
        int fr = fr_in, fq = fq_in; asm volatile("" : "+v"(fr), "+v"(fq));
        const int row0 = u.pm * BM + wr * 64 + fr, col0 = u.pn * BM + wc * 64 + 8 * fq;
        u32x4 w[2][4][2];
#pragma unroll
        for (int ai = 0; ai < 2; ++ai)
#pragma unroll
            for (int m = 0; m < 4; ++m)
#pragma unroll
                for (int bj = 0; bj < 2; ++bj) w[ai][m][bj] = *(const u32x4*)(X1 + (size_t)(row0 + ai * HALF + m * 16) * DM + col0 + bj * 32);
#pragma unroll
        for (int ai = 0; ai < 2; ++ai)
#pragma unroll
            for (int m = 0; m < 4; ++m)
#pragma unroll
                for (int bj = 0; bj < 2; ++bj) unpack8(w[ai][m][bj], acc[ai][bj][m][0], acc[ai][bj][m][1]);
    }
    __device__ __forceinline__ void operator()(const f32x4 (&acc)[2][2][4][2], const Unit& u, int wr, int wc, int fr_in, int fq_in) const {
        int fr = fr_in, fq = fq_in; asm volatile("" : "+v"(fr), "+v"(fq));
        const int row0 = u.pm * BM + wr * 64 + fr, col0 = u.pn * BM + wc * 64 + 8 * fq, t = threadIdx.x;
        f32x4 gv[2][2];
#pragma unroll
        for (int bj = 0; bj < 2; ++bj)
#pragma unroll
            for (int n = 0; n < 2; ++n) gv[bj][n] = *(const f32x4*)(gfin + col0 + bj * 32 + 4 * n);
#pragma unroll
        for (int ai = 0; ai < 2; ++ai)
#pragma unroll
            for (int m = 0; m < 4; ++m) { float q = 0.f;
#pragma unroll
                for (int bj = 0; bj < 2; ++bj) { const f32x4 v0 = acc[ai][bj][m][0], v1 = acc[ai][bj][m][1];
                    q += (v0[0] * v0[0] + v0[1] * v0[1]) + (v0[2] * v0[2] + v0[3] * v0[3]) + (v1[0] * v1[0] + v1[1] * v1[1]) + (v1[2] * v1[2] + v1[3] * v1[3]); }
                q += __shfl_xor(q, 16); q += __shfl_xor(q, 32); if (fq == 0) red[wc * 256 + ai * HALF + wr * 64 + m * 16 + fr] = q; }
        asm volatile("s_waitcnt lgkmcnt(0)" ::: "memory"); __builtin_amdgcn_s_barrier(); asm volatile("" ::: "memory");
        if (t < 256) { const float s = (red[t] + red[256 + t]) + (red[512 + t] + red[768 + t]);
            __hip_atomic_store(slots + (size_t)(u.pm * BM + t) * 4 + u.pn, __builtin_bit_cast(unsigned, s), __ATOMIC_RELAXED, __HIP_MEMORY_SCOPE_AGENT); }
        asm volatile("s_waitcnt vmcnt(0)" ::: "memory");
        __builtin_amdgcn_s_barrier(); asm volatile("" ::: "memory");
        if (t == 0) { unsigned* c = cnt + 64 * u.pm;
            __hip_atomic_fetch_add(c, 1u, __ATOMIC_RELAXED, __HIP_MEMORY_SCOPE_AGENT);
            unsigned sp = 0;
            while (__hip_atomic_load(c, __ATOMIC_RELAXED, __HIP_MEMORY_SCOPE_AGENT) < 4u) { __builtin_amdgcn_s_sleep(1); if (++sp > (1u << 24)) break; }
            __builtin_amdgcn_fence(__ATOMIC_ACQUIRE, "agent"); }
        asm volatile("s_waitcnt vmcnt(0) lgkmcnt(0)" ::: "memory"); __builtin_amdgcn_s_barrier(); asm volatile("" ::: "memory");
        if (t < 256) { const unsigned* sl = slots + (size_t)(u.pm * BM + t) * 4; float s = 0.f;
#pragma unroll
            for (int k = 0; k < 4; ++k) s += __builtin_bit_cast(float, __hip_atomic_load(sl + k, __ATOMIC_RELAXED, __HIP_MEMORY_SCOPE_AGENT));
            red[1024 + t] = 1.0f / sqrtf(s * (1.0f / DM) + EPS); }
        asm volatile("s_waitcnt lgkmcnt(0)" ::: "memory"); __builtin_amdgcn_s_barrier(); asm volatile("" ::: "memory");
#pragma unroll
        for (int ai = 0; ai < 2; ++ai)
#pragma unroll
            for (int m = 0; m < 4; ++m) { const int rl = ai * HALF + wr * 64 + m * 16 + fr; const float r = red[1024 + rl];
#pragma unroll
                for (int bj = 0; bj < 2; ++bj) { const size_t off = (size_t)(u.pm * BM + rl) * DM + col0 + bj * 32;
                    *(f32x4*)(out + off) = acc[ai][bj][m][0] * r * gv[bj][0]; *(f32x4*)(out + off + 4) = acc[ai][bj][m][1] * r * gv[bj][1]; }
                asm volatile("" ::: "memory"); }
    }
};

struct EpiSwiGLU {
    static constexpr bool PERM = true, AFTER_DRAIN = false, INIT = false; static constexpr int MIDK = 0;
    bf16* ACT; const float* ssq; LAS float* red;
    __device__ __forceinline__ void operator()(const f32x4 (&acc)[2][2][4][2], const Unit& u, int wr, int wc, int fr_in, int fq_in) const {
        int fr = fr_in, fq = fq_in; asm volatile("" : "+v"(fr), "+v"(fq));
        const int row0 = u.pm * BM + wr * 64 + fr, col0 = u.pn * HALF + wc * 32 + 8 * fq, t = threadIdx.x;
        if (t < 256) { const f32x4 s4 = *(const f32x4*)(ssq + (size_t)(u.pm * BM + t) * 4); red[t] = __builtin_amdgcn_rsqf(((s4[0] + s4[1]) + (s4[2] + s4[3])) * (1.0f / DM) + EPS); }
        asm volatile("s_waitcnt lgkmcnt(0)" ::: "memory"); __builtin_amdgcn_s_barrier(); asm volatile("" ::: "memory");
#pragma unroll
        for (int ai = 0; ai < 2; ++ai)
#pragma unroll
            for (int m = 0; m < 4; ++m) { const int rl = ai * HALF + wr * 64 + m * 16 + fr; const size_t row = (size_t)(u.pm * BM + rl);
                const float rstd = red[rl];
                const float rl2 = rstd * -1.4426950408889634f, r2 = rstd * rstd;
                f32x4 t0 = acc[ai][0][m][0] * rl2, t1 = acc[ai][0][m][1] * rl2, g0 = acc[ai][0][m][0] * acc[ai][1][m][0], g1 = acc[ai][0][m][1] * acc[ai][1][m][1];
#pragma unroll
                for (int j = 0; j < 4; ++j) { t0[j] = __builtin_amdgcn_rcpf(1.0f + __builtin_amdgcn_exp2f(t0[j])); t1[j] = __builtin_amdgcn_rcpf(1.0f + __builtin_amdgcn_exp2f(t1[j])); }
                g0 = g0 * (t0 * r2); g1 = g1 * (t1 * r2);
                *(u32x4*)(ACT + row * FF + col0) = pack8(g0, g1); }
    }
};
struct EpiDry {
    static constexpr bool PERM = true, AFTER_DRAIN = false, INIT = false; static constexpr int MIDK = 0;
    float* sink;
    __device__ __forceinline__ void operator()(const f32x4 (&acc)[2][2][4][2], const Unit& u, int wr, int wc, int fr_in, int fq_in) const {
        int fr = fr_in, fq = fq_in; asm volatile("" : "+v"(fr), "+v"(fq));
        f32x4 s = (f32x4){0.f, 0.f, 0.f, 0.f};
#pragma unroll
        for (int ai = 0; ai < 2; ++ai)
#pragma unroll
            for (int bj = 0; bj < 2; ++bj)
#pragma unroll
                for (int m = 0; m < 4; ++m) { s += acc[ai][bj][m][0]; s += acc[ai][bj][m][1]; }
        const float t = (s[0] + s[1]) + (s[2] + s[3]);
        if (t == 1.2345e30f) sink[threadIdx.x] = t;
    }
};
}

__device__ __forceinline__ void p0_transpose_item(const float* W, int K, int N, bf16* WT, int mode, int row_off, const float* gain, LAS float* scr, int item, int lane, int pitch = 0, int koff = 0) {
    if (pitch == 0) pitch = K;
    const int nblk = N / 32, kb = item / nblk, nb = item % nblk, k0 = 64 * kb, n0 = 32 * nb;
    { f32x4 wv[8]; float gv[8];
#pragma unroll
      for (int i = 0; i < 8; ++i) { const int kk = (lane >> 3) + 8 * i; wv[i] = *(const f32x4*)(W + (size_t)(k0 + kk) * N + n0 + (lane & 7) * 4); gv[i] = gain ? gain[k0 + kk] : 1.0f; }
#pragma unroll
      for (int i = 0; i < 8; ++i) { const int kk = (lane >> 3) + 8 * i; LAS float* d = scr + kk * 33 + (lane & 7) * 4; d[0] = wv[i].x * gv[i]; d[1] = wv[i].y * gv[i]; d[2] = wv[i].z * gv[i]; d[3] = wv[i].w * gv[i]; } }
    asm volatile("s_waitcnt lgkmcnt(0)" ::: "memory");
    const int c = lane & 7;
#pragma unroll
    for (int j = 0; j < 4; ++j) { const int n = (lane >> 3) + 8 * j; const LAS float* s = scr + (8 * c) * 33 + n;
        u32x4 o; o.x = pk2(s[0 * 33], s[1 * 33]); o.y = pk2(s[2 * 33], s[3 * 33]); o.z = pk2(s[4 * 33], s[5 * 33]); o.w = pk2(s[6 * 33], s[7 * 33]);
        const int col = n0 + n; int orow;
        if (mode == 1) orow = ((col >> 7) << 8) + (col & 127) + row_off;
        else if (mode == 2) { const int a = col & 255; orow = col - a + 128 * ((a >> 5) & 1) + 32 * (a >> 6) + (a & 31); }
        else if (mode == 3) { const int a = col & 255; orow = (col & ~255) + 128 * ((a >> 5) & 1) + 32 * (a >> 6) + (a & 31) + row_off; }
        else orow = col + row_off;
        *(u32x4*)(WT + (size_t)orow * pitch + koff + k0 + 8 * c) = o; }
    asm volatile("s_waitcnt lgkmcnt(0)" ::: "memory");
}

#define MFMA32(a, b, c) __builtin_amdgcn_mfma_f32_32x32x16_bf16((a), (b), (c), 0, 0, 0)
__device__ __forceinline__ int crow(int reg, int h) { return (reg & 3) + 8 * (reg >> 2) + 4 * h; }
__device__ __forceinline__ bf16x8 pack_step(const f32x16& x, int s) {
    u32x4 p;
    asm volatile("v_cvt_pk_bf16_f32 %0, %4, %5\n\tv_cvt_pk_bf16_f32 %1, %6, %7\n\tv_cvt_pk_bf16_f32 %2, %8, %9\n\tv_cvt_pk_bf16_f32 %3, %10, %11\n\ts_nop 1"
                 : "=&v"(p[0]), "=&v"(p[1]), "=&v"(p[2]), "=&v"(p[3])
                 : "v"(x[8 * s]), "v"(x[8 * s + 1]), "v"(x[8 * s + 2]), "v"(x[8 * s + 3]), "v"(x[8 * s + 4]), "v"(x[8 * s + 5]), "v"(x[8 * s + 6]), "v"(x[8 * s + 7]));
    return __builtin_bit_cast(bf16x8, p);
}
__device__ __forceinline__ void tr_read4(unsigned a, s16x4& lo0, s16x4& hi0, s16x4& lo1, s16x4& hi1) {
    asm volatile("ds_read_b64_tr_b16 %0, %4\n\tds_read_b64_tr_b16 %1, %4 offset:1152\n\tds_read_b64_tr_b16 %2, %4 offset:64\n\tds_read_b64_tr_b16 %3, %4 offset:1216\n\ts_waitcnt lgkmcnt(0)"
                 : "=&v"(lo0), "=&v"(hi0), "=&v"(lo1), "=&v"(hi1) : "v"(a) : "memory");
}
constexpr int AT_OPITCH = 128, AT_LSE_OFF = 512 * AT_OPITCH, AT_VST_OFF = AT_LSE_OFF + 2048, AT_VPITCH = 144, AT_VST_BYTES = 32 * AT_VPITCH;
static_assert(AT_VST_OFF + NWAVES * AT_VST_BYTES <= RING_BYTES, "attention LDS");
static_assert(8 * AT_VPITCH == 1152, "tr_read4 offsets");

__device__ __forceinline__ void attn_unit(LAS unsigned char* lds, const bf16* Z, bf16* MERGED, int b, int hq, int chunk, int wid, int lane, int tid) {
    const int r32 = lane & 31, h = lane >> 5;
    const bf16* zb = Z + (size_t)T * 512 + (size_t)b * 36 * SEQ * 64;
    LAS unsigned char* vst = lds + AT_VST_OFF + wid * AT_VST_BYTES;
    LAS float* LSE = (LAS float*)(lds + AT_LSE_OFF);
    const float NEG = -INFINITY;
#pragma unroll 1
    for (int g = 0; g < 3; ++g) {
        const int sh = 2 * g, d = 1 << sh, bpr = 16 >> sh, n = SEQ >> sh, hg = 4 * g + hq;
#pragma unroll 1
        for (int wbi = 0; wbi < 2; ++wbi) {
            const int wb = wid * 2 + wbi, r = wb / bpr, q0 = chunk * (512 >> sh) + 32 * (wb % bpr);
            const int qtok = (q0 + r32) * d + r;
            const int lrow = lane >> 3, lchk = lane & 7;
            const char* qb_ = (const char*)(zb + ((size_t)((hg << 11) + r * n) << 6));
            const char* kb_ = (const char*)(zb + ((size_t)(((12 + hg) << 11) + r * n) << 6));
            const char* vb_ = (const char*)(zb + ((size_t)(((24 + hg) << 11) + r * n) << 6));
            const unsigned toff = (unsigned)(lrow * 128 + lchk * 16), qoff = (unsigned)((q0 + r32) * 128 + 16 * h);
            bf16x8 qf[4];
#pragma unroll
            for (int s = 0; s < 4; ++s) qf[s] = __builtin_bit_cast(bf16x8, *(const u32x4*)(qb_ + qoff + 32 * s));
            bool tvv[5]; int jt[5];
#pragma unroll
            for (int c = 0; c < 5; ++c) { const int j0 = q0 - 64 + 32 * c; tvv[c] = (j0 >= 0 && j0 < n); jt[c] = tvv[c] ? j0 : q0; }
            u32x4 kr[5][4];
#pragma unroll
            for (int c = 0; c < 5; ++c)
#pragma unroll
                for (int i = 0; i < 4; ++i) kr[c][i] = *(const u32x4*)(kb_ + (size_t)((jt[c] + 8 * i) * 128) + toff);
            f32x16 S[5];
#pragma unroll
            for (int c = 0; c < 5; ++c) {
#pragma unroll
                for (int i = 0; i < 4; ++i) *(LAS u32x4*)(vst + (8 * i + lrow) * AT_VPITCH + lchk * 16) = kr[c][i];
                bf16x8 kf[4];
#pragma unroll
                for (int s = 0; s < 4; ++s) kf[s] = __builtin_bit_cast(bf16x8, *(const LAS u32x4*)(vst + r32 * AT_VPITCH + 32 * s + 16 * h));
                f32x16 a;
#pragma unroll
                for (int i = 0; i < 16; ++i) a[i] = 0.f;
#pragma unroll
                for (int s = 0; s < 4; ++s) a = MFMA32(kf[s], qf[s], a);
#pragma unroll
                for (int i = 0; i < 16; ++i) { if (c == 0) a[i] = (crow(i, h) >= r32) ? a[i] : NEG; if (c == 4) a[i] = (crow(i, h) <= r32) ? a[i] : NEG; }
                S[c] = a;
            }
            asm volatile("" ::: "memory");
            u32x4 v4[5][4];
#pragma unroll
            for (int c = 0; c < 3; ++c)
#pragma unroll
                for (int i = 0; i < 4; ++i) v4[c][i] = *(const u32x4*)(vb_ + (size_t)((jt[c] + 8 * i) * 128) + toff);
            float mx = NEG;
#pragma unroll
            for (int c = 0; c < 5; ++c) { float tm = NEG;
#pragma unroll
                for (int i = 0; i < 16; ++i) tm = fmaxf(tm, S[c][i]);
                mx = fmaxf(mx, tvv[c] ? tm : NEG); }
            mx = fmaxf(mx, __shfl_xor(mx, 32));
            float den = 0.f;
#pragma unroll
            for (int c = 0; c < 5; ++c) { const float mxs = tvv[c] ? mx : INFINITY;
#pragma unroll
                for (int i = 0; i < 16; ++i) { const float p = __builtin_amdgcn_exp2f(S[c][i] - mxs); S[c][i] = p; den += p; } }
            den += __shfl_xor(den, 32);
            f32x16 O0, O1;
#pragma unroll
            for (int i = 0; i < 16; ++i) { O0[i] = 0.f; O1[i] = 0.f; }
            const unsigned trbase = (unsigned)(size_t)vst + (4 * h + ((lane & 15) >> 2)) * AT_VPITCH + 32 * ((lane >> 4) & 1) + 8 * (lane & 3);
#pragma unroll
            for (int c = 0; c < 5; ++c) {
#pragma unroll
                for (int i = 0; i < 4; ++i) *(LAS u32x4*)(vst + (8 * i + lrow) * AT_VPITCH + lchk * 16) = v4[c][i];
                if (c == 1) {
#pragma unroll
                    for (int c2 = 3; c2 < 5; ++c2)
#pragma unroll
                        for (int i = 0; i < 4; ++i) v4[c2][i] = *(const u32x4*)(vb_ + (size_t)((jt[c2] + 8 * i) * 128) + toff);
                }
                asm volatile("s_waitcnt lgkmcnt(0)" ::: "memory");
#pragma unroll
                for (int s = 0; s < 2; ++s) {
                    const bf16x8 pf = pack_step(S[c], s);
                    s16x4 lo0, hi0, lo1, hi1;
                    tr_read4(trbase + 16 * s * AT_VPITCH, lo0, hi0, lo1, hi1);
                    const bf16x8 va0 = __builtin_shufflevector(lo0, hi0, 0, 1, 2, 3, 4, 5, 6, 7), va1 = __builtin_shufflevector(lo1, hi1, 0, 1, 2, 3, 4, 5, 6, 7);
                    O0 = MFMA32(va0, pf, O0); O1 = MFMA32(va1, pf, O1);
                }
            }
            const float inv = __builtin_amdgcn_rcpf(den), lse = mx + __builtin_amdgcn_logf(den);
            const int tokidx = qtok - chunk * 512;
            LAS unsigned char* orow = lds + tokidx * AT_OPITCH; const int fsw = (tokidx ^ (tokidx >> 4)) & 15;
            float wo = 0.f, wn = inv, lnew = lse;
            if (g > 0) { const float lold = LSE[tokidx]; const float mxl = fmaxf(lold, lse); lnew = mxl + __builtin_amdgcn_logf(__builtin_amdgcn_exp2f(lold - mxl) + __builtin_amdgcn_exp2f(lse - mxl)); wo = __builtin_amdgcn_exp2f(lold - lnew); wn = __builtin_amdgcn_exp2f(lse - lnew) * inv; }
#pragma unroll
            for (int dt = 0; dt < 2; ++dt)
#pragma unroll
                for (int a4 = 0; a4 < 4; ++a4) {
                    LAS u32x2* p = (LAS u32x2*)(orow + (((dt * 8 + a4 * 2 + h) ^ fsw) << 3));
                    f32x4 v;
#pragma unroll
                    for (int j = 0; j < 4; ++j) v[j] = (dt ? O1[4 * a4 + j] : O0[4 * a4 + j]) * wn;
                    if (g > 0) { const u32x2 ow = *p; v[0] += wo * bflo(ow.x); v[1] += wo * bfhi(ow.x); v[2] += wo * bflo(ow.y); v[3] += wo * bfhi(ow.y); }
                    u32x2 nw; nw.x = pk2(v[0], v[1]); nw.y = pk2(v[2], v[3]); *p = nw;
                }
            if (h == 0) LSE[tokidx] = lnew;
        }
        __syncthreads();
    }
    bf16* mo = MERGED + ((size_t)b * SEQ + chunk * 512) * PMW + 512 + hq * 64;
#pragma unroll
    for (int it = 0; it < 8; ++it) { const int idx = tid + 512 * it, tok = idx >> 3, pc = idx & 7;
        const int fsw = (tok ^ (tok >> 4)) & 15;
        u32x4 w = *(const LAS u32x4*)(lds + tok * AT_OPITCH + ((pc ^ (fsw >> 1)) << 4));
        if (fsw & 1) w = (u32x4){w.z, w.w, w.x, w.y};
        *(u32x4*)(mo + (size_t)tok * PMW + pc * 8) = w; }
    __syncthreads();
}

__device__ __forceinline__ void pool_unit(LAS unsigned char* lds, const bf16* Z, bf16* POOLED, int b, int t0, int wid, int lane, int tid) {
    const bf16* zb = Z + (size_t)b * SEQ * 512;
    { u32x4 rv[10];
#pragma unroll
      for (int k = 0; k < 10; ++k) { int t = t0 - 8 + wid + 8 * k; t = t < 0 ? 0 : (t >= SEQ ? SEQ - 1 : t); rv[k] = *(const u32x4*)(zb + (size_t)t * 512 + lane * 8); }
#pragma unroll
      for (int k = 0; k < 10; ++k) *(LAS u32x4*)(lds + (wid + 8 * k) * 1024 + lane * 16) = rv[k]; }
    __syncthreads();
#pragma unroll 1
    for (int k = 0; k < 8; ++k) { const int gi = (wid + k) & 3, slot = wid * 2 + (k >> 2), tl = slot * 4 + (lane >> 4), cu = gi * 16 + (lane & 15), t = t0 + tl, hw = 1 << gi;
        const int lo = (t - hw) < 0 ? 0 : (t - hw), hi = (t + hw) > SEQ ? SEQ : (t + hw);
        f32x4 s0 = (f32x4){0.f, 0.f, 0.f, 0.f}, s1 = s0;
        for (int j = lo; j < hi; ++j) { const u32x4 w = *(const LAS u32x4*)(lds + (j - t0 + 8) * 1024 + cu * 16); f32x4 a0, a1; ep::unpack8(w, a0, a1); s0 += a0; s1 += a1; }
        const float ic = 1.0f / (float)(hi - lo);
        const u32x4 w = *(const LAS u32x4*)(lds + (tl + 8) * 1024 + cu * 16); f32x4 a0, a1; ep::unpack8(w, a0, a1);
        s0 = s0 * ic - a0; s1 = s1 * ic - a1;
        u32x4 o; o.x = pk2(s0[0], s0[1]); o.y = pk2(s0[2], s0[3]); o.z = pk2(s1[0], s1[1]); o.w = pk2(s1[2], s1[3]);
        *(u32x4*)(POOLED + ((size_t)b * SEQ + t) * PMW + cu * 8) = o; }
    __syncthreads();
}

#define XB_TMO      128
#define XB_XCNT(j)  (256  + 64 * (j))
#define XB_XSUB(j)  (1280 + 64 * (j))
#define XB_XGEN(j)  (2304 + 64 * (j))
#define XB_TOP      3328
#define XB_TOPGEN   3392
#define XCD_BAR_WORDS 3456
#define XB_SPIN_CAP (1u << 18)

__device__ __forceinline__ unsigned xb_ld(unsigned* p)              { return __hip_atomic_load(p, __ATOMIC_RELAXED, __HIP_MEMORY_SCOPE_AGENT); }
__device__ __forceinline__ unsigned xb_add(unsigned* p, unsigned v) { return __hip_atomic_fetch_add(p, v, __ATOMIC_RELAXED, __HIP_MEMORY_SCOPE_AGENT); }
__device__ __forceinline__ unsigned xb_xcc_id() { return (unsigned)__builtin_amdgcn_s_getreg((3 << 11) | 20) & 0xFu; }
#define XB_SPIN(cond, bar) do { unsigned _sp = 0; while (cond) { __builtin_amdgcn_s_sleep(1); \
    if ((++_sp & 255u) == 0u) { if (xb_ld(&(bar)[XB_TMO])) break; if (_sp > XB_SPIN_CAP) { atomicAdd(&(bar)[XB_TMO], 1u); break; } } } } while (0)

struct XcdBarrier {
    unsigned* bar; unsigned x;
    volatile LAS unsigned* st;
};

__device__ __forceinline__ XcdBarrier xcd_barrier_post(unsigned* bar, volatile LAS unsigned* st) {
    XcdBarrier b; b.bar = bar; b.x = xb_xcc_id(); b.st = st;
    if (threadIdx.x == 0) (void)xb_add(&bar[XB_XCNT(b.x)], 1u);
    return b;
}
__device__ __forceinline__ void xcd_barrier_complete(unsigned* bar, unsigned x, unsigned& nloc, unsigned& nx) {
    const unsigned G = gridDim.x * gridDim.y * gridDim.z;
    unsigned sum, cnt, mine, sp = 0u;
    for (;;) {
        sum = 0u; cnt = 0u; mine = 0u;
#pragma unroll
        for (unsigned j = 0; j < 16; ++j) { const unsigned c = xb_ld(&bar[XB_XCNT(j)]); sum += c; cnt += (c > 0u) ? 1u : 0u; mine = (j == x) ? c : mine; }
        if (sum == G) break;
        __builtin_amdgcn_s_sleep(1);
        if ((++sp & 255u) == 0u) { if (xb_ld(&bar[XB_TMO])) break; if (sp > XB_SPIN_CAP) { atomicAdd(&bar[XB_TMO], 1u); break; } }
    }
    nloc = mine > 0u ? mine : 1u; nx = cnt > 0u ? cnt : 1u;
}

__device__ __forceinline__ void xcd_barrier(const XcdBarrier& b) {
    asm volatile("s_waitcnt vmcnt(0)" ::: "memory");
    __syncthreads();
    if (threadIdx.x == 0) {
        unsigned* bar = b.bar;
        __builtin_amdgcn_s_waitcnt(0);
        unsigned nloc = b.st[0], nx = b.st[1];
        if (nloc == 0u) { xcd_barrier_complete(bar, b.x, nloc, nx); b.st[0] = nloc; b.st[1] = nx; }
        const unsigned old = xb_add(&bar[XB_XSUB(b.x)], 1u);
        const unsigned gen = old / nloc;
        if (old + 1u == (gen + 1u) * nloc) {
            __builtin_amdgcn_fence(__ATOMIC_RELEASE, "agent");
            asm volatile("s_waitcnt vmcnt(0)" ::: "memory");
            const unsigned og = xb_add(&bar[XB_TOP], 1u);
            const unsigned tg = og / nx;
            if (og + 1u == (tg + 1u) * nx) xb_add(&bar[XB_TOPGEN], 1u);
            else XB_SPIN(xb_ld(&bar[XB_TOPGEN]) == tg, bar);
            __builtin_amdgcn_fence(__ATOMIC_ACQUIRE, "agent");
            xb_add(&bar[XB_XGEN(b.x)], 1u);
            asm volatile("s_waitcnt vmcnt(0)" ::: "memory");
        } else {
            XB_SPIN(xb_ld(&bar[XB_XGEN(b.x)]) == gen, bar);
            __builtin_amdgcn_fence(__ATOMIC_ACQUIRE, "agent");
            asm volatile("s_waitcnt vmcnt(0)" ::: "memory");
        }
    }
    __syncthreads();
}

struct Args { const float* in[16]; float* out; unsigned char* ws; int ph_lo, ph_hi; };

__global__ void __launch_bounds__(NWAVES * 64, 2) mk_fwd(Args args) {
    extern __shared__ __attribute__((aligned(16))) unsigned char lds_raw[];
    LAS unsigned char* lds = (LAS unsigned char*)lds_raw;
    cg::grid_group grid = cg::this_grid();
    const int tid = threadIdx.x, lane = tid & 63, wid = __builtin_amdgcn_readfirstlane(tid >> 6);
    const int G = gridDim.x, bx = blockIdx.x;
    const int vcu = (G % 8 == 0) ? (bx % 8) * (G / 8) + bx / 8 : bx;
    const __attribute__((address_space(4))) unsigned char* ka = (const __attribute__((address_space(4))) unsigned char*)__builtin_amdgcn_kernarg_segment_ptr();
    typedef const float* cfp_t; typedef unsigned char* ucp_t;
#define ARG_IN(i) (*(volatile cfp_t __attribute__((address_space(4)))*)(ka + 8 * (i)))
#define ARG_OUT() ((float*)*(volatile cfp_t __attribute__((address_space(4)))*)(ka + 128))
#define ARG_WS() (*(volatile ucp_t __attribute__((address_space(4)))*)(ka + 136))
#define WSP(off) ((bf16*)(ws + (off)))
    const int lo = args.ph_lo, hi = args.ph_hi;
    volatile LAS unsigned* xb_st = (volatile LAS unsigned*)(lds + RING_BYTES + 8192);
    if (tid < 2) xb_st[tid] = 0u;
    __syncthreads();
    const unsigned sk8 = (unsigned)((bx >> 3) & 7);
#ifndef PH_MASK
#define PH_MASK 255
#endif
#define IN(k) (((PH_MASK >> (k)) & 1) && lo <= (k) && (k) < hi)
#define SEAM(k) do { if (IN(k) && IN((k) + 1)) { if ((k) == 0) grid.sync(); else { XcdBarrier xb_; xb_.bar = (unsigned*)ARG_WS(); xb_.x = xb_xcc_id(); xb_.st = xb_st; xcd_barrier(xb_); } } } while (0)
#ifndef PROBE_DUP
#define PROBE_DUP -1
#endif
#define REPS(k) for (int rep_ = 0; rep_ < ((PROBE_DUP == (k)) ? 2 : 1); ++rep_)

    REPS(0) if (IN(0)) { if (rep_) grid.sync();
        unsigned char* ws = ARG_WS();
        bf16* W1T = WSP(WS_W1T); bf16* WPT = WSP(WS_WPT); bf16* WOT = WSP(WS_WOT); bf16* WGUT = WSP(WS_WGUT); bf16* WDT = WSP(WS_WDT);
        float* ROPE = (float*)(ws + WS_ROPE); bf16* XB = WSP(WS_XB);
        LAS float* scr = (LAS float*)(lds + wid * 16384);
        const int gw = vcu * NWAVES + wid, NGW = G * NWAVES;
        constexpr int I_IN = (DM / 64) * (ZW / 32), I_G = (DM / 64) * (GW / 32), I_UA = (256 / 64) * (DM / 32), I_O = (DM / 64) * (DM / 32), I_F = (DM / 64) * (FF / 32), I_D = (FF / 64) * (DM / 32);
        constexpr int NITEMS = I_IN + I_G + I_UA + I_O + 2 * I_F + I_D;
        for (int it = gw; it < NITEMS; it += NGW) {
            int r = it;
            if (r < I_IN) { p0_transpose_item(ARG_IN(3), DM, ZW, W1T, 2, 0, ARG_IN(2), scr, r, lane); continue; } r -= I_IN;
            if (r < I_G) { p0_transpose_item(ARG_IN(8), DM, GW, W1T, 3, ZW, ARG_IN(2), scr, r, lane); continue; } r -= I_G;
            if (r < I_UA) { p0_transpose_item(ARG_IN(7), 256, DM, WPT, 3, 0, nullptr, scr, r, lane, PMW, 512); continue; } r -= I_UA;
            if (r < I_O) { p0_transpose_item(ARG_IN(10), DM, DM, WOT, 3, 0, nullptr, scr, r, lane); continue; } r -= I_O;
            if (r < I_F) { p0_transpose_item(ARG_IN(12), DM, FF, WGUT, 1, 0, ARG_IN(11), scr, r, lane); continue; } r -= I_F;
            if (r < I_F) { p0_transpose_item(ARG_IN(13), DM, FF, WGUT, 1, 128, ARG_IN(11), scr, r, lane); continue; } r -= I_F;
            p0_transpose_item(ARG_IN(14), FF, DM, WDT, 3, 0, nullptr, scr, r, lane);
        }
        for (int it = vcu; it < 128; it += G) { const int g = it >> 5, cb = (it >> 1) & 15, n = (it & 1) * 512 + tid;
            const float* maps = ARG_IN(4) + (size_t)(g * 128 + cb * 8) * 128; const float* sc = ARG_IN(5) + g * 128; const float* wu = ARG_IN(6) + (size_t)g * 128 * DM + n;
            float a[8];
#pragma unroll
            for (int ci = 0; ci < 8; ++ci) a[ci] = 0.f;
#pragma unroll 16
            for (int dd = 0; dd < 128; ++dd) { const float w = wu[(size_t)dd * DM] * sc[dd];
#pragma unroll
                for (int ci = 0; ci < 8; ++ci) a[ci] += maps[ci * 128 + dd] * w; }
            u32x4 o; o.x = pk2(a[0], a[1]); o.y = pk2(a[2], a[3]); o.z = pk2(a[4], a[5]); o.w = pk2(a[6], a[7]);
            { const int a_ = n & 255, np = (n & ~255) + 128 * ((a_ >> 5) & 1) + 32 * (a_ >> 6) + (a_ & 31);
              *(u32x4*)(WPT + (size_t)np * PMW + g * 128 + cb * 8) = o; } }
        for (int i = vcu * 512 + tid; i < 384 * 64; i += G * 512) ((unsigned*)(ws + WS_CNT))[i] = 0u;
        for (int i = vcu * 512 + tid; i < 4096; i += G * 512) ((unsigned*)ws)[i] = 0u;
        for (int i = vcu * 512 + tid; i < SEQ * 8; i += G * 512) { const int pos = i >> 3, f = i & 7;
            const float invf = exp2f(-(float)f * (18.931568569324174f / 8.0f));
            const double rev = (double)pos * (double)invf * 0.15915494309189535; const float fr_ = (float)(rev - __builtin_rint(rev));
            const float sn = __builtin_amdgcn_sinf(fr_), cs = __builtin_amdgcn_cosf(fr_);
            ROPE[pos * 16 + f] = cs; ROPE[pos * 16 + 8 + f] = sn; }
        for (int m0 = gw * 4; m0 < T; m0 += NGW * 4) {
            f32x4 v[4][4];
#pragma unroll
            for (int rr = 0; rr < 4; ++rr) { const int m = m0 + rr;
                const float* xrow = (m < 32 * SEQ) ? ARG_IN(0) + (size_t)m * DM : ARG_IN(1) + (size_t)(m - 32 * SEQ) * DM;
                const f32x4* xr = (const f32x4*)xrow + lane;
#pragma unroll
                for (int j = 0; j < 4; ++j) v[rr][j] = xr[64 * j]; }
#pragma unroll
            for (int rr = 0; rr < 4; ++rr) { float s = 0.f;
#pragma unroll
                for (int j = 0; j < 4; ++j) s += (v[rr][j].x * v[rr][j].x + v[rr][j].y * v[rr][j].y) + (v[rr][j].z * v[rr][j].z + v[rr][j].w * v[rr][j].w);
                const float rstd = 1.0f / sqrtf(wave_sum(s) * (1.0f / DM) + EPS);
                u32x2* o8 = (u32x2*)(XB + (size_t)(m0 + rr) * DM) + lane;
#pragma unroll
                for (int j = 0; j < 4; ++j) { u32x2 w; w.x = pk2(v[rr][j].x * rstd, v[rr][j].y * rstd); w.y = pk2(v[rr][j].z * rstd, v[rr][j].w * rstd); o8[64 * j] = w; } }
        }
        __syncthreads();
    }
    SEAM(0);
    if (IN(0) && IN(1)) (void)xcd_barrier_post((unsigned*)ARG_WS(), xb_st);
    REPS(1) if (IN(1)) { if (rep_) grid.sync();
        unsigned char* ws = ARG_WS();
        pg8::Gemm g{WSP(WS_XB), WSP(WS_W1T), T, N1, DM}; pg8::StaticOrder S; S.init(T, N1, G, bx);
        { LAS float* bl = (LAS float*)(lds + RING_BYTES); const float* bg = ARG_IN(9);
          for (int i = tid; i < GW; i += NWAVES * 64) bl[i] = bg[i] * -1.4426950408889634f;
          __syncthreads(); }
        ep::EpiZG E{WSP(WS_Z), (bf16*)ARG_OUT(), (const LAS float*)(lds + RING_BYTES), (const float*)(ws + WS_ROPE)};
        skew_wait((unsigned)SKEW1 * (unsigned)((bx < 128 ? 0 : 4) + ((bx >> 3) & 3)));
        pg8::gemm_phase<ep::EpiZG, pg8::StaticOrder, true, true>(lds, g, S, E);
    }
    SEAM(1);
    REPS(2) if (IN(2)) { if (rep_) grid.sync();
        unsigned char* ws = ARG_WS(); const bf16* Z = WSP(WS_Z); bf16* MERGED = WSP(WS_PM); bf16* POOLED = WSP(WS_PM);
        for (int u = vcu; u < NB * 16; u += G) attn_unit(lds, Z, MERGED, u >> 4, (u >> 2) & 3, u & 3, wid, lane, tid);
        for (int u = vcu; u < NB * 32; u += G) pool_unit(lds, Z, POOLED, u >> 5, (u & 31) * 64, wid, lane, tid);
#if PROBE_DUP == 22
        for (int u = vcu; u < NB * 32; u += G) pool_unit(lds, Z, POOLED, u >> 5, (u & 31) * 64, wid, lane, tid);
#endif
    }
    SEAM(2);
    REPS(3) if (IN(3)) { if (rep_) grid.sync();
        unsigned char* ws = ARG_WS();
        pg8::Gemm g{WSP(WS_PM), WSP(WS_WPT), T, DM, PMW}; pg8::StaticOrder S; S.init(T, DM, G, bx); ep::EpiGateCat E{WSP(WS_Z), (const bf16*)ARG_OUT()};
        pg8::gemm_phase<ep::EpiGateCat, pg8::StaticOrder, true, true>(lds, g, S, E);
    }
    SEAM(3);
    REPS(4) if (IN(4)) { if (rep_) grid.sync();
        unsigned char* ws = ARG_WS();
        pg8::Gemm g{WSP(WS_Z), WSP(WS_WOT), T, DM, DM}; pg8::StaticOrder S; S.init(T, DM, G, bx);
        skew_wait((unsigned)SKEW4 * sk8);
        ep::EpiRes E{ARG_IN(0), ARG_IN(1) - (size_t)32 * SEQ * DM, WSP(WS_XB), (float*)(ws + WS_SSQ2), (LAS float*)(lds + RING_BYTES)};
        pg8::gemm_phase<ep::EpiRes, pg8::StaticOrder, true, true>(lds, g, S, E);
    }
    SEAM(4);
    REPS(5) if (IN(5)) { if (rep_) grid.sync();
        unsigned char* ws = ARG_WS();
        pg8::Gemm g{WSP(WS_XB), WSP(WS_WGUT), T, 2 * FF, DM}; pg8::StaticOrder S; S.init(T, 2 * FF, G, bx);
        skew_wait((unsigned)SKEW5 * sk8);
#if PROBE_DUP == 5
        if (rep_ == 0) { ep::EpiDry E{(float*)(ws + WS_SLOTS)}; pg8::gemm_phase<ep::EpiDry, pg8::StaticOrder, true, true>(lds, g, S, E); } else
#endif
        { ep::EpiSwiGLU E{WSP(WS_Z), (const float*)(ws + WS_SSQ2), (LAS float*)(lds + RING_BYTES)};
        pg8::gemm_phase<ep::EpiSwiGLU, pg8::StaticOrder, true, true>(lds, g, S, E); }
    }
    SEAM(5);
    if (IN(6)) {
        unsigned char* ws = ARG_WS();
        pg8::Gemm g{WSP(WS_Z), WSP(WS_WDT), T, DM, FF}; pg8::StaticOrder S; S.init(T, DM, G, bx);
        skew_wait((unsigned)SKEW6 * sk8);
        ep::EpiFinal E{ARG_OUT(), WSP(WS_XB), ARG_IN(15), (unsigned*)(ws + WS_SLOTS), (unsigned*)(ws + WS_CNT), (LAS float*)(lds + RING_BYTES)};
        pg8::gemm_phase<ep::EpiFinal, pg8::StaticOrder, true, true>(lds, g, S, E);
    }
#undef IN
#undef SEAM
}

extern "C" void kernel_launch(void* const* d_in, const int* in_sizes, int n_in, void* d_out, int out_size, void* d_ws, size_t ws_size, hipStream_t stream) {
    static int grid = 0;
    if (grid == 0) {
        if (n_in != 16 || in_sizes[0] != 32 * SEQ * DM || in_sizes[1] != 16 * SEQ * DM || out_size != T * DM || ws_size < WS_END) {
            fprintf(stderr, "kernel_launch: unexpected shapes (n_in %d out %d ws %zu)\n", n_in, out_size, ws_size); grid = -1; return; }
        int dev = 0, cus = 0, per_cu = 0;
        hipGetDevice(&dev); hipDeviceGetAttribute(&cus, hipDeviceAttributeMultiprocessorCount, dev);
        hipFuncSetAttribute((const void*)mk_fwd, hipFuncAttributeMaxDynamicSharedMemorySize, LDS_BYTES);
        hipOccupancyMaxActiveBlocksPerMultiprocessor(&per_cu, (const void*)mk_fwd, NWAVES * 64, LDS_BYTES);
        (void)hipGetLastError();
        if (per_cu < 1) per_cu = 1;
        grid = cus * 1;
    }
    if (grid < 0) return;
    Args a{};
    for (int i = 0; i < 16; ++i) a.in[i] = (const float*)d_in[i];
    a.out = (float*)d_out; a.ws = (unsigned char*)d_ws;
#if MK_ONE_LAUNCH
    a.ph_lo = 0; a.ph_hi = 7;
    void* kargs[] = {&a};
    hipError_t e = hipLaunchCooperativeKernel((const void*)mk_fwd, dim3(grid), dim3(NWAVES * 64), kargs, LDS_BYTES, stream);
    if (e != hipSuccess) fprintf(stderr, "cooperative launch failed: %s (grid %d)\n", hipGetErrorString(e), grid);
#else
    for (int p = 0; p < 7; ++p) { a.ph_lo = p; a.ph_hi = p + 1; hipLaunchKernelGGL(mk_fwd, dim3(grid), dim3(NWAVES * 64), LDS_BYTES, stream, a); }
#endif
}
```

```cpp
#include <hip/hip_runtime.h>
#include <cstdio>
#include <cstdint>
namespace pg8 {
#define PG8_LAS __attribute__((address_space(3)))
typedef unsigned short bf16_t;
typedef short bf16x8 __attribute__((ext_vector_type(8)));
typedef float f32x4 __attribute__((ext_vector_type(4)));
typedef unsigned u32x4 __attribute__((ext_vector_type(4)));
constexpr int BM = 256, BK = 64, HALF = 128, HTB = HALF * BK * 2  , STAGE_BYTES = 8 * HTB, NXCD = 8, WGM = 8;

__host__ __device__ __forceinline__ int lds_byte(int r, int c) { const int st = (r >> 4) * 2 + (c >> 5), rr = r & 15, cc = c & 31, ob = rr * 64 + cc * 2; return st * 1024 + (ob ^ (((ob >> 9) & 1) << 5)); }
__host__ __device__ __forceinline__ void stage_rc(int b, int& R, int& C) { const int st = b / 1024, sb = b % 1024, swz = sb ^ (((sb >> 9) & 1) << 5); R = (st >> 1) * 16 + swz / 64; C = (st & 1) * 32 + (swz % 64) / 2; }
__host__ __device__ __forceinline__ int perm32(int rho) { const int n = rho >> 4, i = rho & 15; return 8 * (i >> 2) + 4 * n + (i & 3); }

struct Unit { int pm, pn; };
struct Gemm { const bf16_t* A; const bf16_t* Bt; int M, N, K; };

struct StaticOrder {
    int nM, nN, nwg, G, c;
    __host__ __device__ void init(int M, int N, int G_, int c_) { nM = M / BM; nN = N / BM; nwg = nM * nN; G = G_; c = c_; }
    __host__ __device__ bool next(int i, Unit& u) const {
        const long L = (long)i * G + c; if (L >= nwg) return false;
        int wgid = (int)L; { const int q = nwg / NXCD, r = nwg % NXCD, xcd = wgid % NXCD, off = wgid / NXCD; wgid = (xcd < r ? xcd * (q + 1) : r * (q + 1) + (xcd - r) * q) + off; }
        const int nig = WGM * nN, gid = wgid / nig, fm = gid * WGM, gsz = (nM - fm) < WGM ? (nM - fm) : WGM;
        u.pm = fm + ((wgid % nig) % gsz); u.pn = (wgid % nig) / gsz; return true;
    }
    __device__ __forceinline__ void a_ready(const Unit&) const {}
    __device__ __forceinline__ void done(const Unit&) const {}
};

__device__ __forceinline__ unsigned cvt_pk_bf16(float lo, float hi) { unsigned r; asm volatile("v_cvt_pk_bf16_f32 %0, %1, %2" : "=v"(r) : "v"(lo), "v"(hi)); return r; }
typedef float f32x2 __attribute__((ext_vector_type(2)));
__device__ __forceinline__ f32x2 gelu_pk(f32x2 v) {
    const f32x2 av = __builtin_elementwise_abs(v), d = av * 0.2316418882f + 1.0f;
    f32x2 t; t.x = __builtin_amdgcn_rcpf(d.x); t.y = __builtin_amdgcn_rcpf(d.y);
    f32x2 q = t * 0.5307027145f + (-0.7265760135f); q = q * t + 0.7107068705f; q = q * t + (-0.142248368f); q = q * t + 0.127414796f; q = q * t;
    const f32x2 s = (v * v) * (-0.72134752044f);
    f32x2 e; e.x = __builtin_amdgcn_exp2f(s.x); e.y = __builtin_amdgcn_exp2f(s.y);
    const f32x2 m = v * (q * e), r = v - m;
    f32x2 o; o.x = v.x < 0.f ? m.x : r.x; o.y = v.y < 0.f ? m.y : r.y; return o;
}

template <int ACT  > struct EpiBf16 {
    static constexpr bool PERM = true, AFTER_DRAIN = false; static_assert(ACT == 0 || ACT == 1, "EpiBf16: ACT is 0 (none) or 1 (gelu_pk)");
    bf16_t* O; int ldc; const float* bias; int split_cols; size_t split_stride; float scale0;
    __device__ __forceinline__ void operator()(const f32x4 (&acc)[2][2][4][2], const Unit& u, int wr, int wc, int fr, int fq) const {
        const int row0 = u.pm * BM + wr * 64 + fr; int colt = u.pn * BM; bf16_t* base = O;
        float sc = 1.f; if (split_cols) { const int t = colt / split_cols; base += (size_t)t * split_stride; colt -= t * split_cols; if (t == 0) sc = scale0; }
        const int col0 = colt + wc * 32 + 8 * fq, bcol0 = u.pn * BM + wc * 32 + 8 * fq;
        f32x4 bv[2][2];
#pragma unroll
        for (int bj = 0; bj < 2; ++bj)
#pragma unroll
            for (int n = 0; n < 2; ++n) bv[bj][n] = bias ? *(const f32x4*)(bias + bcol0 + bj * HALF + 4 * n) : (f32x4){0.f, 0.f, 0.f, 0.f};
#pragma unroll
        for (int ai = 0; ai < 2; ++ai)
#pragma unroll
            for (int m = 0; m < 4; ++m) { bf16_t* rowp = base + (size_t)(row0 + ai * HALF + m * 16) * ldc + col0;
#pragma unroll
                for (int bj = 0; bj < 2; ++bj) { f32x4 v0 = acc[ai][bj][m][0] + bv[bj][0], v1 = acc[ai][bj][m][1] + bv[bj][1];
                    if (ACT == 1) { f32x2 a = gelu_pk((f32x2){v0[0], v0[1]}), b = gelu_pk((f32x2){v0[2], v0[3]}), c = gelu_pk((f32x2){v1[0], v1[1]}), d = gelu_pk((f32x2){v1[2], v1[3]});
                        v0 = (f32x4){a.x, a.y, b.x, b.y}; v1 = (f32x4){c.x, c.y, d.x, d.y}; }
                    v0 = v0 * sc; v1 = v1 * sc; u32x4 w; w.x = cvt_pk_bf16(v0[0], v0[1]); w.y = cvt_pk_bf16(v0[2], v0[3]); w.z = cvt_pk_bf16(v1[0], v1[1]); w.w = cvt_pk_bf16(v1[2], v1[3]);
                    *(u32x4*)(rowp + bj * HALF) = w; } }
    }
};
template <class Epi, class Sched, bool ALIGN_EPI = false, bool SP2 = false>
__device__ __forceinline__ void gemm_phase(PG8_LAS unsigned char* lds, const Gemm g, const Sched& S, const Epi& E) {
    const int tid = threadIdx.x, wid = __builtin_amdgcn_readfirstlane(tid >> 6), lane = tid & 63, wr = wid >> 2, wc = wid & 3, fr = lane & 15, fq = lane >> 4;
    const int K = g.K, nt = K / BK;
    unsigned voffA[2], voffB[2];
#pragma unroll
    for (int i = 0; i < 2; ++i) { int R, C; stage_rc(tid * 16 + i * 8192, R, C); const int Rb = Epi::PERM ? ((R & ~31) + perm32(R & 31)) : R;
        voffA[i] = (unsigned)(R * K + C) * 2u; voffB[i] = (unsigned)(Rb * K + C) * 2u; }
    const size_t kstep = (size_t)(BK * 2);
    const size_t hstep = (size_t)HALF * K * 2;
    const size_t tstep = 2 * hstep;
    const unsigned ldsw = (unsigned)wid * 1024u;
    const int aoff = lds_byte(wr * 64 + fr, fq * 8), boff = lds_byte(wc * 32 + fr, fq * 8);
#define PG8_SA(b, h) (((b) * 2 + (h)) * HTB)
#define PG8_SB(b, h) ((4 + (b) * 2 + (h)) * HTB)
#define PG8_STAGE(bufoff, gbase, voff) do { _Pragma("unroll") for (int _i = 0; _i < 2; ++_i) \
        __builtin_amdgcn_global_load_lds((const unsigned*)((const char*)(gbase) + (voff)[_i]), (PG8_LAS unsigned*)(lds + (bufoff) + ldsw + _i * 8192), 16, 0, 0); } while (0)
#define PG8_LDA(dst, b, h) do { _Pragma("unroll") for (int m = 0; m < 4; ++m) _Pragma("unroll") for (int k = 0; k < 2; ++k) dst[m][k] = *(const PG8_LAS bf16x8*)(lds + PG8_SA(b, h) + aoff + m * 2048 + k * 1024); } while (0)
#define PG8_LDB(dst, b, h) do { _Pragma("unroll") for (int n = 0; n < 2; ++n) _Pragma("unroll") for (int k = 0; k < 2; ++k) dst[n][k] = *(const PG8_LAS bf16x8*)(lds + PG8_SB(b, h) + boff + n * 2048 + k * 1024); } while (0)
#define PG8_MMA(ai, bj, At, Bt) do { __builtin_amdgcn_s_setprio(1); _Pragma("unroll") for (int m = 0; m < 4; ++m) _Pragma("unroll") for (int n = 0; n < 2; ++n) _Pragma("unroll") for (int k = 0; k < 2; ++k) \
        acc[ai][bj][m][n] = __builtin_amdgcn_mfma_f32_16x16x32_bf16(Bt[n][k], At[m][k], acc[ai][bj][m][n], 0, 0, 0); __builtin_amdgcn_s_setprio(0); } while (0)
#define PG8_WAIT_V(n) asm volatile("s_waitcnt vmcnt(" #n ")" ::: "memory")
#define PG8_WAIT_L(n) asm volatile("s_waitcnt lgkmcnt(" #n ")" ::: "memory")
#define PG8_BAR __builtin_amdgcn_s_barrier()
#define PG8_SCHED __builtin_amdgcn_sched_barrier(0)
    Unit cur, nxt; int ui = 0;
    if (!S.next(0, cur)) return;
    f32x4 acc[2][2][4][2];
    if constexpr (Epi::INIT) E.init(acc, cur, wr, wc, fr, fq); else {
#pragma unroll
    for (int a = 0; a < 2; ++a)
#pragma unroll
        for (int b = 0; b < 2; ++b)
#pragma unroll
            for (int m = 0; m < 4; ++m)
#pragma unroll
                for (int n = 0; n < 2; ++n) acc[a][b][m][n] = (f32x4){0.f, 0.f, 0.f, 0.f};
    }
    bf16x8 At[4][2], B0[2][2], B1[2][2];
    const char* cA = (const char*)g.A + (size_t)cur.pm * tstep; const char* cB = (const char*)g.Bt + (size_t)cur.pn * tstep;
    S.a_ready(cur);
    if constexpr (SP2) {
        PG8_STAGE(PG8_SB(0, 0), cB, voffB); PG8_STAGE(PG8_SB(0, 1), cB + hstep, voffB); PG8_STAGE(PG8_SA(0, 0), cA, voffA); PG8_STAGE(PG8_SA(0, 1), cA + hstep, voffA);
        if (wr == 1) PG8_BAR;
        PG8_WAIT_V(2); PG8_BAR;
        PG8_STAGE(PG8_SB(1, 0), cB + kstep, voffB); PG8_STAGE(PG8_SA(1, 0), cA + kstep, voffA); PG8_STAGE(PG8_SB(1, 1), cB + hstep + kstep, voffB);
        PG8_WAIT_V(6); PG8_BAR;
    } else {
        PG8_STAGE(PG8_SB(0, 0), cB, voffB); PG8_STAGE(PG8_SA(0, 0), cA, voffA); PG8_STAGE(PG8_SB(0, 1), cB + hstep, voffB); PG8_STAGE(PG8_SA(0, 1), cA + hstep, voffA);
        if (wr == 1) PG8_BAR;
        PG8_WAIT_V(4); PG8_BAR;
        PG8_STAGE(PG8_SB(1, 0), cB + kstep, voffB); PG8_STAGE(PG8_SA(1, 0), cA + kstep, voffA); PG8_STAGE(PG8_SB(1, 1), cB + hstep + kstep, voffB);
        PG8_WAIT_V(6); PG8_BAR;
    }
    for (;;) {
        const bool has_next = S.next(ui + 1, nxt);
        const char* nA = has_next ? (const char*)g.A + (size_t)nxt.pm * tstep : cA; const char* nB = has_next ? (const char*)g.Bt + (size_t)nxt.pn * tstep : cB;
_Pragma("unroll 1")
        for (int t = 0; t < nt; t += 2) {
            if constexpr (Epi::MIDK > 0) { if (t == Epi::MIDK) E.mid(acc, cur, wr, wc, fr, fq); }
            const bool last = (t == nt - 2);
            const char* a1 = cA + (size_t)(t + 1) * kstep;
            const char* a2 = last ? nA : cA + (size_t)(t + 2) * kstep; const char* b2 = last ? nB : cB + (size_t)(t + 2) * kstep;
            const char* a3 = a2 + kstep; const char* b3 = b2 + kstep;
            if (last && has_next) S.a_ready(nxt);
            if constexpr (SP2) {
            PG8_LDB(B0, 0, 0); PG8_LDB(B1, 0, 1); PG8_SCHED; PG8_LDA(At, 0, 0); PG8_STAGE(PG8_SA(1, 1), a1 + hstep, voffA);
            PG8_WAIT_V(8); PG8_WAIT_L(0); PG8_BAR; PG8_MMA(0, 0, At, B0); PG8_MMA(0, 1, At, B1); PG8_BAR; PG8_SCHED;
            PG8_LDA(At, 0, 1); PG8_STAGE(PG8_SB(0, 0), b2, voffB); PG8_STAGE(PG8_SB(0, 1), b2 + hstep, voffB); PG8_STAGE(PG8_SA(0, 0), a2, voffA);
            PG8_WAIT_V(8); PG8_WAIT_L(0); PG8_BAR; PG8_MMA(1, 0, At, B0); PG8_MMA(1, 1, At, B1); PG8_BAR; PG8_SCHED;
            PG8_LDB(B0, 1, 0); PG8_LDB(B1, 1, 1); PG8_SCHED; PG8_LDA(At, 1, 0); PG8_STAGE(PG8_SA(0, 1), a2 + hstep, voffA);
            PG8_WAIT_V(8); PG8_WAIT_L(0); PG8_BAR; PG8_MMA(0, 0, At, B0); PG8_MMA(0, 1, At, B1); PG8_BAR; PG8_SCHED;
            PG8_LDA(At, 1, 1); PG8_STAGE(PG8_SB(1, 0), b3, voffB); PG8_STAGE(PG8_SB(1, 1), b3 + hstep, voffB); PG8_STAGE(PG8_SA(1, 0), a3, voffA);
            PG8_WAIT_V(8); PG8_WAIT_L(0); PG8_BAR; PG8_MMA(1, 0, At, B0); PG8_MMA(1, 1, At, B1); PG8_BAR; PG8_SCHED;
            } else {
            PG8_LDB(B0, 0, 0); PG8_SCHED; PG8_LDA(At, 0, 0); PG8_STAGE(PG8_SA(1, 1), a1 + hstep, voffA);
            PG8_WAIT_L(8); PG8_BAR; PG8_WAIT_L(0); PG8_MMA(0, 0, At, B0); PG8_BAR; PG8_SCHED;
            PG8_LDB(B1, 0, 1); PG8_STAGE(PG8_SB(0, 0), b2, voffB);
            PG8_BAR; PG8_WAIT_L(0); PG8_MMA(0, 1, At, B1); PG8_BAR;
            PG8_LDA(At, 0, 1); PG8_STAGE(PG8_SA(0, 0), a2, voffA);
            PG8_BAR; PG8_WAIT_L(0); PG8_MMA(1, 0, At, B0); PG8_BAR; PG8_SCHED;
            PG8_STAGE(PG8_SB(0, 1), b2 + hstep, voffB);
            PG8_WAIT_V(6); PG8_BAR; PG8_MMA(1, 1, At, B1); PG8_BAR;
            PG8_LDB(B0, 1, 0); PG8_SCHED; PG8_LDA(At, 1, 0); PG8_STAGE(PG8_SA(0, 1), a2 + hstep, voffA);
            PG8_WAIT_L(8); PG8_BAR; PG8_WAIT_L(0); PG8_MMA(0, 0, At, B0); PG8_BAR; PG8_SCHED;
            PG8_LDB(B1, 1, 1); PG8_STAGE(PG8_SB(1, 0), b3, voffB);
            PG8_BAR; PG8_WAIT_L(0); PG8_MMA(0, 1, At, B1); PG8_BAR;
            PG8_LDA(At, 1, 1); PG8_STAGE(PG8_SA(1, 0), a3, voffA);
            PG8_BAR; PG8_WAIT_L(0); PG8_MMA(1, 0, At, B0); PG8_BAR; PG8_SCHED;
            PG8_STAGE(PG8_SB(1, 1), b3 + hstep, voffB);
            PG8_WAIT_V(6); PG8_BAR; PG8_MMA(1, 1, At, B1); PG8_BAR;
            }
        }
        if constexpr (ALIGN_EPI) { if (wr == 0) PG8_BAR; }
        if constexpr (!Epi::AFTER_DRAIN) { E(acc, cur, wr, wc, fr, fq); S.done(cur); }
        if (!has_next) break;
        if constexpr (Epi::INIT) E.init(acc, nxt, wr, wc, fr, fq); else {
#pragma unroll
        for (int a = 0; a < 2; ++a)
#pragma unroll
            for (int b = 0; b < 2; ++b)
#pragma unroll
                for (int m = 0; m < 4; ++m)
#pragma unroll
                    for (int n = 0; n < 2; ++n) acc[a][b][m][n] = (f32x4){0.f, 0.f, 0.f, 0.f};
        }
        cur = nxt; cA = nA; cB = nB; ++ui;
        if constexpr (ALIGN_EPI) { if (wr == 1) PG8_BAR; }
    }
    PG8_WAIT_V(0);
    if constexpr (!ALIGN_EPI) { if (wr == 0) PG8_BAR; }
    PG8_BAR;
    if constexpr (Epi::AFTER_DRAIN) { E.fused(acc, cur, wr, wc, fr, fq, lds, wid, lane); S.done(cur); }
#undef PG8_SA
#undef PG8_SB
#undef PG8_STAGE
#undef PG8_LDA
#undef PG8_LDB
#undef PG8_MMA
#undef PG8_WAIT_V
#undef PG8_WAIT_L
#undef PG8_BAR
#undef PG8_SCHED
}
}

#include <hip/hip_cooperative_groups.h>
namespace cg = cooperative_groups;

#ifndef SKEW1
#define SKEW1 0
#define SKEW3 0
#define SKEW4 0
#define SKEW5 0
#define SKEW6 0
#endif
#ifndef MK_ONE_LAUNCH
#define MK_ONE_LAUNCH 1
#endif

#define LAS __attribute__((address_space(3)))
typedef unsigned short bf16;
typedef float f32x4 __attribute__((ext_vector_type(4)));
typedef float f32x16 __attribute__((ext_vector_type(16)));
typedef unsigned u32x4 __attribute__((ext_vector_type(4)));
typedef unsigned u32x2 __attribute__((ext_vector_type(2)));
typedef short bf16x8 __attribute__((ext_vector_type(8)));
typedef short s16x4 __attribute__((ext_vector_type(4)));

constexpr int NWAVES = 8;
constexpr int SEQ = 2048, DM = 1024, NB = 48, T = NB * SEQ;
constexpr int ZW = 2816, GW = 2048, FF = 2816;
constexpr int N1 = ZW + GW;
constexpr float EPS = 1e-6f;
constexpr int LDS_BYTES = 147456, RING_BYTES = 131072;

constexpr size_t MiB = 1u << 20;
constexpr size_t WS_W1T = 1 * MiB, WS_WPT = 11 * MiB, WS_WUAT = 12 * MiB, WS_WOT = 13 * MiB, WS_WGUT = 15 * MiB, WS_WDT = 26 * MiB;
constexpr size_t WS_ROPE = 32 * MiB, WS_SSQ2 = 34 * MiB, WS_SLOTS = 40 * MiB, WS_CNT = 44 * MiB;
constexpr size_t WS_XB = 48 * MiB;
constexpr size_t WS_PM = WS_XB;
constexpr int PMW = 768;
constexpr size_t WS_Z = 240 * MiB;
constexpr size_t WS_END = 768 * MiB;

__device__ __forceinline__ unsigned f2bf(float f) { unsigned u = __builtin_bit_cast(unsigned, f); return (u + 0x7fffu + ((u >> 16) & 1u)) >> 16; }
typedef __bf16 bf16x2_g __attribute__((ext_vector_type(2))); typedef float f32x2_g __attribute__((ext_vector_type(2)));
__device__ __forceinline__ unsigned pk2(float lo, float hi) { const f32x2_g v = {lo, hi}; return __builtin_bit_cast(unsigned, __builtin_convertvector(v, bf16x2_g)); }
__device__ __forceinline__ float bflo(unsigned w) { return __builtin_bit_cast(float, w << 16); }
__device__ __forceinline__ float bfhi(unsigned w) { return __builtin_bit_cast(float, w & 0xffff0000u); }
__device__ __forceinline__ float wave_sum(float v) {
#pragma unroll
    for (int o = 1; o < 64; o <<= 1) v += __shfl_xor(v, o);
    return v;
}
__device__ __forceinline__ float sigmoidf_(float x) { return __builtin_amdgcn_rcpf(1.0f + __builtin_amdgcn_exp2f(x * -1.4426950408889634f)); }
__device__ __forceinline__ void skew_wait(unsigned ticks) { if (ticks) { const unsigned long long t0 = __builtin_amdgcn_s_memrealtime(); while (__builtin_amdgcn_s_memrealtime() - t0 < ticks) __builtin_amdgcn_s_sleep(4); } }

namespace ep {
using pg8::Unit; using pg8::cvt_pk_bf16;
constexpr int BM = 256, HALF = 128;

typedef __bf16 bf16x2_t __attribute__((ext_vector_type(2)));
typedef float f32x2_t __attribute__((ext_vector_type(2)));
__device__ __forceinline__ unsigned cvt2(float a, float b) { const f32x2_t v = {a, b}; return __builtin_bit_cast(unsigned, __builtin_convertvector(v, bf16x2_t)); }
__device__ __forceinline__ u32x4 pack8(const f32x4 v0, const f32x4 v1) {
    u32x4 w; w.x = cvt2(v0[0], v0[1]); w.y = cvt2(v0[2], v0[3]); w.z = cvt2(v1[0], v1[1]); w.w = cvt2(v1[2], v1[3]); return w;
}
__device__ __forceinline__ void unpack8(const u32x4 w, f32x4& v0, f32x4& v1) {
    v0 = (f32x4){bflo(w.x), bfhi(w.x), bflo(w.y), bfhi(w.y)}; v1 = (f32x4){bflo(w.z), bfhi(w.z), bflo(w.w), bfhi(w.w)};
}

struct EpiZG {
    static constexpr bool PERM = true, AFTER_DRAIN = false, INIT = false; static constexpr int MIDK = 0;
    bf16* Z; bf16* G; const LAS float* bias; const float* rope;
    __device__ __forceinline__ bf16* zptr(int pn, int bj, int wc, int fq, int row) const {
        if (pn < 2) return Z + (size_t)row * 512 + pn * BM + wc * 64 + bj * 32 + 8 * fq;
        const int hidx = (pn - 2) * 4 + wc, sh = 2 * ((hidx % 12) >> 2), tok = row & (SEQ - 1);
        const int pos = ((tok & ((1 << sh) - 1)) << (11 - sh)) | (tok >> sh);
        return Z + (size_t)T * 512 + ((size_t)((((row >> 11) * 36 + hidx) << 11) + pos) << 6) + bj * 32 + 8 * fq;
    }
    __device__ __forceinline__ void operator()(const f32x4 (&acc)[2][2][4][2], const Unit& u, int wr, int wc, int fr_in, int fq_in) const {
        int fr = fr_in, fq = fq_in; asm volatile("" : "+v"(fr), "+v"(fq));
        const int row0 = u.pm * BM + wr * 64 + fr;
        const int cl = wc * 64 + 8 * fq;
        if (u.pn >= 11) {
            const int gc0 = (u.pn - 11) * BM + cl;
            f32x4 bv[2][2];
#pragma unroll
            for (int bj = 0; bj < 2; ++bj)
#pragma unroll
                for (int n = 0; n < 2; ++n) bv[bj][n] = *(const LAS f32x4*)(bias + gc0 + bj * 32 + 4 * n);
#pragma unroll
            for (int ai = 0; ai < 2; ++ai)
#pragma unroll
                for (int m = 0; m < 4; ++m) { bf16* rowp = G + (size_t)(row0 + ai * HALF + m * 16) * GW + gc0;
#pragma unroll
                    for (int bj = 0; bj < 2; ++bj) { f32x4 v0 = acc[ai][bj][m][0] * -1.4426950408889634f + bv[bj][0], v1 = acc[ai][bj][m][1] * -1.4426950408889634f + bv[bj][1];
#pragma unroll
                        for (int j = 0; j < 4; ++j) { v0[j] = __builtin_amdgcn_rcpf(1.0f + __builtin_amdgcn_exp2f(v0[j])); v1[j] = __builtin_amdgcn_rcpf(1.0f + __builtin_amdgcn_exp2f(v1[j])); }
                        *(u32x4*)(rowp + bj * 32) = pack8(v0, v1); }
                    asm volatile("" ::: "memory"); }
        } else {
            const bool rope_tile = (u.pn >= 2 && u.pn < 8);
            const float sc = (u.pn >= 2 && u.pn < 5) ? 0.18033688011112042f : 1.0f;
            if (rope_tile) {
                const float sgn = (fq == 0) ? -1.0f : 1.0f; const bool act = fq < 2;
#pragma unroll
                for (int am = 0; am < 4; ++am) { const int ai = am >> 1;
                    f32x4 tb[2][4];
#pragma unroll
                    for (int mm = 0; mm < 2; ++mm) { const int m = (am & 1) * 2 + mm; const int row = row0 + ai * HALF + m * 16; const f32x4* tp = (const f32x4*)(rope + (row & (SEQ - 1)) * 16);
#pragma unroll
                        for (int k = 0; k < 4; ++k) tb[mm][k] = tp[k]; }
#pragma unroll
                    for (int mm = 0; mm < 2; ++mm) { const int m = (am & 1) * 2 + mm; const int row = row0 + ai * HALF + m * 16;
                        const f32x4 c0 = tb[mm][0], c1 = tb[mm][1], s0 = tb[mm][2] * sgn, s1 = tb[mm][3] * sgn;
                        f32x4 v0 = acc[ai][0][m][0], v1 = acc[ai][0][m][1], p0, p1;
#pragma unroll
                        for (int j = 0; j < 4; ++j) { p0[j] = __shfl_xor(v0[j], 16); p1[j] = __shfl_xor(v1[j], 16); }
                        if (act) { v0 = v0 * c0 + p0 * s0; v1 = v1 * c1 + p1 * s1; }
                        *(u32x4*)zptr(u.pn, 0, wc, fq, row) = pack8(v0 * sc, v1 * sc);
                        *(u32x4*)zptr(u.pn, 1, wc, fq, row) = pack8(acc[ai][1][m][0] * sc, acc[ai][1][m][1] * sc); }
                    asm volatile("" ::: "memory"); }
            } else {
#pragma unroll
                for (int ai = 0; ai < 2; ++ai)
#pragma unroll
                    for (int m = 0; m < 4; ++m) { const int row = row0 + ai * HALF + m * 16;
#pragma unroll
                        for (int bj = 0; bj < 2; ++bj) *(u32x4*)zptr(u.pn, bj, wc, fq, row) = pack8(acc[ai][bj][m][0] * sc, acc[ai][bj][m][1] * sc); }
            }
        }
    }
};

struct EpiGateCat {
    static constexpr bool PERM = true, AFTER_DRAIN = false, INIT = false; static constexpr int MIDK = 8;
    bf16* MB; const bf16* G;
    __device__ __forceinline__ void mid(f32x4 (&acc)[2][2][4][2], const Unit& u, int wr, int wc, int fr_in, int fq_in) const {
        int fr = fr_in, fq = fq_in; asm volatile("" : "+v"(fr), "+v"(fq));
        const int row0 = u.pm * BM + wr * 64 + fr, col0 = u.pn * BM + wc * 64 + 8 * fq;
#pragma unroll
        for (int ai = 0; ai < 2; ++ai) {
            u32x4 ga[4][2], gb[4][2];
#pragma unroll
            for (int m = 0; m < 4; ++m) { const bf16* gp = G + (size_t)(row0 + ai * HALF + m * 16) * GW + col0;
#pragma unroll
                for (int bj = 0; bj < 2; ++bj) { ga[m][bj] = *(const u32x4*)(gp + bj * 32); gb[m][bj] = *(const u32x4*)(gp + DM + bj * 32); } }
#pragma unroll
            for (int m = 0; m < 4; ++m)
#pragma unroll
                for (int bj = 0; bj < 2; ++bj) { f32x4 a0, a1, b0, b1; unpack8(ga[m][bj], a0, a1); unpack8(gb[m][bj], b0, b1);
#pragma unroll
                    for (int j = 0; j < 4; ++j) { a0[j] *= __builtin_amdgcn_rcpf(fmaxf(b0[j], 1e-30f)); a1[j] *= __builtin_amdgcn_rcpf(fmaxf(b1[j], 1e-30f)); }
                    acc[ai][bj][m][0] *= a0; acc[ai][bj][m][1] *= a1; }
            asm volatile("" ::: "memory"); }
    }
    __device__ __forceinline__ void operator()(const f32x4 (&acc)[2][2][4][2], const Unit& u, int wr, int wc, int fr_in, int fq_in) const {
        int fr = fr_in, fq = fq_in; asm volatile("" : "+v"(fr), "+v"(fq));
        const int row0 = u.pm * BM + wr * 64 + fr, col0 = u.pn * BM + wc * 64 + 8 * fq;
        u32x4 gb[2][4][2];
#pragma unroll
        for (int ai = 0; ai < 2; ++ai)
#pragma unroll
            for (int m = 0; m < 4; ++m)
#pragma unroll
                for (int bj = 0; bj < 2; ++bj) gb[ai][m][bj] = *(const u32x4*)(G + (size_t)(row0 + ai * HALF + m * 16) * GW + DM + col0 + bj * 32);
#pragma unroll
        for (int ai = 0; ai < 2; ++ai)
#pragma unroll
            for (int m = 0; m < 4; ++m)
#pragma unroll
                for (int bj = 0; bj < 2; ++bj) { f32x4 b0, b1; unpack8(gb[ai][m][bj], b0, b1);
                    *(u32x4*)(MB + (size_t)(row0 + ai * HALF + m * 16) * DM + col0 + bj * 32) = pack8(acc[ai][bj][m][0] * b0, acc[ai][bj][m][1] * b1); }
    }
};

struct EpiRes {
    static constexpr bool PERM = true, AFTER_DRAIN = false, INIT = true; static constexpr int MIDK = 0;
    const float* base_lo; const float* base_hi; bf16* XB_; float* ssq; LAS float* red;
    __device__ __forceinline__ void init(f32x4 (&acc)[2][2][4][2], const Unit& u, int wr, int wc, int fr_in, int fq_in) const {
        int fr = fr_in, fq = fq_in; asm volatile("" : "+v"(fr), "+v"(fq));
        const int row0 = u.pm * BM + wr * 64 + fr, col0 = u.pn * BM + wc * 64 + 8 * fq;
        const float* base = (u.pm < 256) ? base_lo : base_hi;
#pragma unroll
        for (int ai = 0; ai < 2; ++ai)
#pragma unroll
            for (int m = 0; m < 4; ++m)
#pragma unroll
                for (int bj = 0; bj < 2; ++bj) { const size_t off = (size_t)(row0 + ai * HALF + m * 16) * DM + col0 + bj * 32;
                    acc[ai][bj][m][0] = *(const f32x4*)(base + off); acc[ai][bj][m][1] = *(const f32x4*)(base + off + 4); }
    }
    __device__ __forceinline__ void operator()(const f32x4 (&acc)[2][2][4][2], const Unit& u, int wr, int wc, int fr_in, int fq_in) const {
        int fr = fr_in, fq = fq_in; asm volatile("" : "+v"(fr), "+v"(fq));
        const int row0 = u.pm * BM + wr * 64 + fr, col0 = u.pn * BM + wc * 64 + 8 * fq;
#pragma unroll
        for (int ai = 0; ai < 2; ++ai)
#pragma unroll
            for (int m = 0; m < 4; ++m) { const size_t row = (size_t)(row0 + ai * HALF + m * 16); float q = 0.f;
#pragma unroll
                for (int bj = 0; bj < 2; ++bj) { const size_t off = row * DM + col0 + bj * 32;
                    const f32x4 v0 = acc[ai][bj][m][0], v1 = acc[ai][bj][m][1];
                    *(u32x4*)(XB_ + off) = pack8(v0, v1);
                    q += (v0[0] * v0[0] + v0[1] * v0[1]) + (v0[2] * v0[2] + v0[3] * v0[3]) + (v1[0] * v1[0] + v1[1] * v1[1]) + (v1[2] * v1[2] + v1[3] * v1[3]); }
                q += __shfl_xor(q, 16); q += __shfl_xor(q, 32); if (fq == 0) red[wc * 256 + ai * HALF + wr * 64 + m * 16 + fr] = q; }
        asm volatile("s_waitcnt lgkmcnt(0)" ::: "memory"); __builtin_amdgcn_s_barrier(); asm volatile("" ::: "memory");
        const int t = threadIdx.x;
        if (t < 256) ssq[(size_t)(u.pm * BM + t) * 4 + u.pn] = (red[t] + red[256 + t]) + (red[512 + t] + red[768 + t]);
    }
};

struct EpiFinal {
    static constexpr bool PERM = true, AFTER_DRAIN = false, INIT = true; static constexpr int MIDK = 0;
    float* out; const bf16* X1; const float* gfin; unsigned* slots; unsigned* cnt; LAS float* red;
    __device__ __forceinline__ void init(f32x4 (&acc)[2][2][4][2], const Unit& u, int wr, int wc, int fr_in, int fq_in) const {
        int fr = fr_in, fq = fq_in; asm volatile("" : "+v"(fr), "+v"(fq));
        const int row0 = u.pm * BM + wr * 64 + fr, col0 = u.pn * BM + wc * 64 + 8 * fq;
        u32x4 w[2][4][2];
#pragma unroll
        for (int ai = 0; ai < 2; ++ai)
#pragma unroll
            for (int m = 0; m < 4; ++m)
#pragma unroll
                for (int bj = 0; bj < 2; ++bj) w[ai][m][bj] = *(const u32x4*)(X1 + (size_t)(row0 + ai * HALF + m * 16) * DM + col0 + bj * 32);
#pragma unroll
        for (int ai = 0; ai < 2; ++ai)
#pragma unroll
            for (int m = 0; m < 4; ++m)
#pragma unroll
                for (int bj = 0; bj < 2; ++bj) unpack8(w[ai][m][bj], acc[ai][bj][m][0], acc[ai][bj][m][1]);
    }
    __device__ __forceinline__ void operator()(const f32x4 (&acc)[2][2][4][2], const Unit& u, int wr, int wc, int fr_in, int fq_in) const {
        int fr = fr_in, fq = fq_in; asm volatile("" : "+v"(fr), "+v"(fq));
        const int row0 = u.pm * BM + wr * 64 + fr, col0 = u.pn * BM + wc * 64 + 8 * fq, t = threadIdx.x;
        f32x4 gv[2][2];
#pragma unroll
        for (int bj = 0; bj < 2; ++bj)
#pragma unroll
            for (int n = 0; n < 2; ++n) gv[bj][n] = *(const f32x4*)(gfin + col0 + bj * 32 + 4 * n);
#pragma unroll
        for (int ai = 0; ai < 2; ++ai)
#pragma unroll
            for (int m = 0; m < 4; ++m) { float q = 0.f;
#pragma unroll
                for (int bj = 0; bj < 2; ++bj) { const f32x4 v0 = acc[ai][bj][m][0], v1 = acc[ai][bj][m][1];
                    q += (v0[0] * v0[0] + v0[1] * v0[1]) + (v0[2] * v0[2] + v0[3] * v0[3]) + (v1[0] * v1[0] + v1[1] * v1[1]) + (v1[2] * v1[2] + v1[3] * v1[3]); }
                q += __shfl_xor(q, 16); q += __shfl_xor(q, 32); if (fq == 0) red[wc * 256 + ai * HALF + wr * 64 + m * 16 + fr] = q; }
        asm volatile("s_waitcnt lgkmcnt(0)" ::: "memory"); __builtin_amdgcn_s_barrier(); asm volatile("" ::: "memory");
        if (t < 256) { const float s = (red[t] + red[256 + t]) + (red[512 + t] + red[768 + t]);
            __hip_atomic_store(slots + (size_t)(u.pm * BM + t) * 4 + u.pn, __builtin_bit_cast(unsigned, s), __ATOMIC_RELAXED, __HIP_MEMORY_SCOPE_AGENT); }
        asm volatile("s_waitcnt vmcnt(0)" ::: "memory");
        __builtin_amdgcn_s_barrier(); asm volatile("" ::: "memory");
        if (t == 0) { unsigned* c = cnt + 64 * u.pm;
            __hip_atomic_fetch_add(c, 1u, __ATOMIC_RELAXED, __HIP_MEMORY_SCOPE_AGENT);
            unsigned sp = 0;
            while (__hip_atomic_load(c, __ATOMIC_RELAXED, __HIP_MEMORY_SCOPE_AGENT) < 4u) { __builtin_amdgcn_s_sleep(1); if (++sp > (1u << 24)) break; }
            __builtin_amdgcn_fence(__ATOMIC_ACQUIRE, "agent"); }
        asm volatile("s_waitcnt vmcnt(0) lgkmcnt(0)" ::: "memory"); __builtin_amdgcn_s_barrier(); asm volatile("" ::: "memory");
        if (t < 256) { const unsigned* sl = slots + (size_t)(u.pm * BM + t) * 4; float s = 0.f;
#pragma unroll
            for (int k = 0; k < 4; ++k) s += __builtin_bit_cast(float, __hip_atomic_load(sl + k, __ATOMIC_RELAXED, __HIP_MEMORY_SCOPE_AGENT));
            red[1024 + t] = 1.0f / sqrtf(s * (1.0f / DM) + EPS); }
        asm volatile("s_waitcnt lgkmcnt(0)" ::: "memory"); __builtin_amdgcn_s_barrier(); asm volatile("" ::: "memory");
#pragma unroll
        for (int ai = 0; ai < 2; ++ai)
#pragma unroll
            for (int m = 0; m < 4; ++m) { const int rl = ai * HALF + wr * 64 + m * 16 + fr; const float r = red[1024 + rl];
#pragma unroll
                for (int bj = 0; bj < 2; ++bj) { const size_t off = (size_t)(u.pm * BM + rl) * DM + col0 + bj * 32;
                    *(f32x4*)(out + off) = acc[ai][bj][m][0] * r * gv[bj][0]; *(f32x4*)(out + off + 4) = acc[ai][bj][m][1] * r * gv[bj][1]; }
                asm volatile("" ::: "memory"); }
    }
};

struct EpiSwiGLU {
    static constexpr bool PERM = true, AFTER_DRAIN = false, INIT = false; static constexpr int MIDK = 0;
    bf16* ACT; const float* ssq; LAS float* red;
    __device__ __forceinline__ void operator()(const f32x4 (&acc)[2][2][4][2], const Unit& u, int wr, int wc, int fr_in, int fq_in) const {
        int fr = fr_in, fq = fq_in; asm volatile("" : "+v"(fr), "+v"(fq));
        const int row0 = u.pm * BM + wr * 64 + fr, col0 = u.pn * HALF + wc * 32 + 8 * fq, t = threadIdx.x;
        if (t < 256) { const f32x4 s4 = *(const f32x4*)(ssq + (size_t)(u.pm * BM + t) * 4); red[t] = __builtin_amdgcn_rsqf(((s4[0] + s4[1]) + (s4[2] + s4[3])) * (1.0f / DM) + EPS); }
        asm volatile("s_waitcnt lgkmcnt(0)" ::: "memory"); __builtin_amdgcn_s_barrier(); asm volatile("" ::: "memory");
#pragma unroll
        for (int ai = 0; ai < 2; ++ai)
#pragma unroll
            for (int m = 0; m < 4; ++m) { const int rl = ai * HALF + wr * 64 + m * 16 + fr; const size_t row = (size_t)(u.pm * BM + rl);
                const float rstd = red[rl];
                const float rl2 = rstd * -1.4426950408889634f, r2 = rstd * rstd;
                f32x4 t0 = acc[ai][0][m][0] * rl2, t1 = acc[ai][0][m][1] * rl2, g0 = acc[ai][0][m][0] * acc[ai][1][m][0], g1 = acc[ai][0][m][1] * acc[ai][1][m][1];
#pragma unroll
                for (int j = 0; j < 4; ++j) { t0[j] = __builtin_amdgcn_rcpf(1.0f + __builtin_amdgcn_exp2f(t0[j])); t1[j] = __builtin_amdgcn_rcpf(1.0f + __builtin_amdgcn_exp2f(t1[j])); }
                g0 = g0 * (t0 * r2); g1 = g1 * (t1 * r2);
                *(u32x4*)(ACT + row * FF + col0) = pack8(g0, g1); }
    }
};
struct EpiDry {
    static constexpr bool PERM = true, AFTER_DRAIN = false, INIT = false; static constexpr int MIDK = 0;
    float* sink;
    __device__ __forceinline__ void operator()(const f32x4 (&acc)[2][2][4][2], const Unit& u, int wr, int wc, int fr_in, int fq_in) const {
        int fr = fr_in, fq = fq_in; asm volatile("" : "+v"(fr), "+v"(fq));
        f32x4 s = (f32x4){0.f, 0.f, 0.f, 0.f};
#pragma unroll
        for (int ai = 0; ai < 2; ++ai)
#pragma unroll
            for (int bj = 0; bj < 2; ++bj)
#pragma unroll
                for (int m = 0; m < 4; ++m) { s += acc[ai][bj][m][0]; s += acc[ai][bj][m][1]; }
        const float t = (s[0] + s[1]) + (s[2] + s[3]);
        if (t == 1.2345e30f) sink[threadIdx.x] = t;
    }
};
}

__device__ __forceinline__ void p0_transpose_item(const float* W, int K, int N, bf16* WT, int mode, int row_off, const float* gain, LAS float* scr, int item, int lane, int pitch = 0, int koff = 0) {
    if (pitch == 0) pitch = K;
    const int nblk = N / 32, kb = item / nblk, nb = item % nblk, k0 = 64 * kb, n0 = 32 * nb;
    { f32x4 wv[8]; float gv[8];
#pragma unroll
      for (int i = 0; i < 8; ++i) { const int kk = (lane >> 3) + 8 * i; wv[i] = *(const f32x4*)(W + (size_t)(k0 + kk) * N + n0 + (lane & 7) * 4); gv[i] = gain ? gain[k0 + kk] : 1.0f; }
#pragma unroll
      for (int i = 0; i < 8; ++i) { const int kk = (lane >> 3) + 8 * i; LAS float* d = scr + kk * 33 + (lane & 7) * 4; d[0] = wv[i].x * gv[i]; d[1] = wv[i].y * gv[i]; d[2] = wv[i].z * gv[i]; d[3] = wv[i].w * gv[i]; } }
    asm volatile("s_waitcnt lgkmcnt(0)" ::: "memory");
    const int c = lane & 7;
#pragma unroll
    for (int j = 0; j < 4; ++j) { const int n = (lane >> 3) + 8 * j; const LAS float* s = scr + (8 * c) * 33 + n;
        u32x4 o; o.x = pk2(s[0 * 33], s[1 * 33]); o.y = pk2(s[2 * 33], s[3 * 33]); o.z = pk2(s[4 * 33], s[5 * 33]); o.w = pk2(s[6 * 33], s[7 * 33]);
        const int col = n0 + n; int orow;
        if (mode == 1) orow = ((col >> 7) << 8) + (col & 127) + row_off;
        else if (mode == 2) { const int a = col & 255; orow = col - a + 128 * ((a >> 5) & 1) + 32 * (a >> 6) + (a & 31); }
        else if (mode == 3) { const int a = col & 255; orow = (col & ~255) + 128 * ((a >> 5) & 1) + 32 * (a >> 6) + (a & 31) + row_off; }
        else orow = col + row_off;
        *(u32x4*)(WT + (size_t)orow * pitch + koff + k0 + 8 * c) = o; }
    asm volatile("s_waitcnt lgkmcnt(0)" ::: "memory");
}

#define MFMA32(a, b, c) __builtin_amdgcn_mfma_f32_32x32x16_bf16((a), (b), (c), 0, 0, 0)
__device__ __forceinline__ int crow(int reg, int h) { return (reg & 3) + 8 * (reg >> 2) + 4 * h; }
__device__ __forceinline__ bf16x8 pack_step(const f32x16& x, int s) {
    u32x4 p;
    asm volatile("v_cvt_pk_bf16_f32 %0, %4, %5\n\tv_cvt_pk_bf16_f32 %1, %6, %7\n\tv_cvt_pk_bf16_f32 %2, %8, %9\n\tv_cvt_pk_bf16_f32 %3, %10, %11\n\ts_nop 1"
                 : "=&v"(p[0]), "=&v"(p[1]), "=&v"(p[2]), "=&v"(p[3])
                 : "v"(x[8 * s]), "v"(x[8 * s + 1]), "v"(x[8 * s + 2]), "v"(x[8 * s + 3]), "v"(x[8 * s + 4]), "v"(x[8 * s + 5]), "v"(x[8 * s + 6]), "v"(x[8 * s + 7]));
    return __builtin_bit_cast(bf16x8, p);
}
__device__ __forceinline__ void tr_read4(unsigned a, s16x4& lo0, s16x4& hi0, s16x4& lo1, s16x4& hi1) {
    asm volatile("ds_read_b64_tr_b16 %0, %4\n\tds_read_b64_tr_b16 %1, %4 offset:1152\n\tds_read_b64_tr_b16 %2, %4 offset:64\n\tds_read_b64_tr_b16 %3, %4 offset:1216\n\ts_waitcnt lgkmcnt(0)"
                 : "=&v"(lo0), "=&v"(hi0), "=&v"(lo1), "=&v"(hi1) : "v"(a) : "memory");
}
constexpr int AT_OPITCH = 128, AT_LSE_OFF = 512 * AT_OPITCH, AT_VST_OFF = AT_LSE_OFF + 2048, AT_VPITCH = 144, AT_VST_BYTES = 32 * AT_VPITCH;
static_assert(AT_VST_OFF + NWAVES * AT_VST_BYTES <= RING_BYTES, "attention LDS");
static_assert(8 * AT_VPITCH == 1152, "tr_read4 offsets");

__device__ __forceinline__ void attn_unit(LAS unsigned char* lds, const bf16* Z, bf16* MERGED, int b, int hq, int chunk, int wid, int lane, int tid) {
    const int r32 = lane & 31, h = lane >> 5;
    const bf16* zb = Z + (size_t)T * 512 + (size_t)b * 36 * SEQ * 64;
    LAS unsigned char* vst = lds + AT_VST_OFF + wid * AT_VST_BYTES;
    LAS float* LSE = (LAS float*)(lds + AT_LSE_OFF);
    const float NEG = -INFINITY;
#pragma unroll 1
    for (int g = 0; g < 3; ++g) {
        const int sh = 2 * g, d = 1 << sh, bpr = 16 >> sh, n = SEQ >> sh, hg = 4 * g + hq;
#pragma unroll 1
        for (int wbi = 0; wbi < 2; ++wbi) {
            const int wb = wid * 2 + wbi, r = wb / bpr, q0 = chunk * (512 >> sh) + 32 * (wb % bpr);
            const int qtok = (q0 + r32) * d + r;
            const int lrow = lane >> 3, lchk = lane & 7;
            const char* qb_ = (const char*)(zb + ((size_t)((hg << 11) + r * n) << 6));
            const char* kb_ = (const char*)(zb + ((size_t)(((12 + hg) << 11) + r * n) << 6));
            const char* vb_ = (const char*)(zb + ((size_t)(((24 + hg) << 11) + r * n) << 6));
            const unsigned toff = (unsigned)(lrow * 128 + lchk * 16);
            u32x4 qr[4];
#pragma unroll
            for (int i = 0; i < 4; ++i) qr[i] = *(const u32x4*)(qb_ + (size_t)((q0 + 8 * i) * 128) + toff);
            bool tvv[5]; int jt[5];
#pragma unroll
            for (int c = 0; c < 5; ++c) { const int j0 = q0 - 64 + 32 * c; tvv[c] = (j0 >= 0 && j0 < n); jt[c] = tvv[c] ? j0 : q0; }
            u32x4 kr[5][4];
#pragma unroll
            for (int c = 0; c < 5; ++c)
#pragma unroll
                for (int i = 0; i < 4; ++i) kr[c][i] = *(const u32x4*)(kb_ + (size_t)((jt[c] + 8 * i) * 128) + toff);
            bf16x8 qf[4];
#pragma unroll
            for (int i = 0; i < 4; ++i) *(LAS u32x4*)(vst + (8 * i + lrow) * AT_VPITCH + lchk * 16) = qr[i];
#pragma unroll
            for (int s = 0; s < 4; ++s) qf[s] = __builtin_bit_cast(bf16x8, *(const LAS u32x4*)(vst + r32 * AT_VPITCH + 32 * s + 16 * h));
            f32x16 S[5];
#pragma unroll
            for (int c = 0; c < 5; ++c) {
#pragma unroll
                for (int i = 0; i < 4; ++i) *(LAS u32x4*)(vst + (8 * i + lrow) * AT_VPITCH + lchk * 16) = kr[c][i];
                bf16x8 kf[4];
#pragma unroll
                for (int s = 0; s < 4; ++s) kf[s] = __builtin_bit_cast(bf16x8, *(const LAS u32x4*)(vst + r32 * AT_VPITCH + 32 * s + 16 * h));
                f32x16 a;
#pragma unroll
                for (int i = 0; i < 16; ++i) a[i] = 0.f;
#pragma unroll
                for (int s = 0; s < 4; ++s) a = MFMA32(kf[s], qf[s], a);
#pragma unroll
                for (int i = 0; i < 16; ++i) { if (c == 0) a[i] = (crow(i, h) >= r32) ? a[i] : NEG; if (c == 4) a[i] = (crow(i, h) <= r32) ? a[i] : NEG; }
                S[c] = a;
            }
            asm volatile("" ::: "memory");
            u32x4 v4[5][4];
#pragma unroll
            for (int c = 0; c < 3; ++c)
#pragma unroll
                for (int i = 0; i < 4; ++i) v4[c][i] = *(const u32x4*)(vb_ + (size_t)((jt[c] + 8 * i) * 128) + toff);
            float mx = NEG;
#pragma unroll
            for (int c = 0; c < 5; ++c) { float tm = NEG;
#pragma unroll
                for (int i = 0; i < 16; ++i) tm = fmaxf(tm, S[c][i]);
                mx = fmaxf(mx, tvv[c] ? tm : NEG); }
            mx = fmaxf(mx, __shfl_xor(mx, 32));
            float den = 0.f;
#pragma unroll
            for (int c = 0; c < 5; ++c) { const float mxs = tvv[c] ? mx : INFINITY;
#pragma unroll
                for (int i = 0; i < 16; ++i) { const float p = __builtin_amdgcn_exp2f(S[c][i] - mxs); S[c][i] = p; den += p; } }
            den += __shfl_xor(den, 32);
            f32x16 O0, O1;
#pragma unroll
            for (int i = 0; i < 16; ++i) { O0[i] = 0.f; O1[i] = 0.f; }
            const unsigned trbase = (unsigned)(size_t)vst + (4 * h + ((lane & 15) >> 2)) * AT_VPITCH + 32 * ((lane >> 4) & 1) + 8 * (lane & 3);
#pragma unroll
            for (int c = 0; c < 5; ++c) {
#pragma unroll
                for (int i = 0; i < 4; ++i) *(LAS u32x4*)(vst + (8 * i + lrow) * AT_VPITCH + lchk * 16) = v4[c][i];
                if (c == 1) {
#pragma unroll
                    for (int c2 = 3; c2 < 5; ++c2)
#pragma unroll
                        for (int i = 0; i < 4; ++i) v4[c2][i] = *(const u32x4*)(vb_ + (size_t)((jt[c2] + 8 * i) * 128) + toff);
                }
                asm volatile("s_waitcnt lgkmcnt(0)" ::: "memory");
#pragma unroll
                for (int s = 0; s < 2; ++s) {
                    const bf16x8 pf = pack_step(S[c], s);
                    s16x4 lo0, hi0, lo1, hi1;
                    tr_read4(trbase + 16 * s * AT_VPITCH, lo0, hi0, lo1, hi1);
                    const bf16x8 va0 = __builtin_shufflevector(lo0, hi0, 0, 1, 2, 3, 4, 5, 6, 7), va1 = __builtin_shufflevector(lo1, hi1, 0, 1, 2, 3, 4, 5, 6, 7);
                    O0 = MFMA32(va0, pf, O0); O1 = MFMA32(va1, pf, O1);
                }
            }
            const float inv = __builtin_amdgcn_rcpf(den), lse = mx + __builtin_amdgcn_logf(den);
            const int tokidx = qtok - chunk * 512;
            LAS unsigned char* orow = lds + tokidx * AT_OPITCH; const int fsw = (tokidx ^ (tokidx >> 4)) & 15;
            float wo = 0.f, wn = inv, lnew = lse;
            if (g > 0) { const float lold = LSE[tokidx]; const float mxl = fmaxf(lold, lse); lnew = mxl + __builtin_amdgcn_logf(__builtin_amdgcn_exp2f(lold - mxl) + __builtin_amdgcn_exp2f(lse - mxl)); wo = __builtin_amdgcn_exp2f(lold - lnew); wn = __builtin_amdgcn_exp2f(lse - lnew) * inv; }
#pragma unroll
            for (int dt = 0; dt < 2; ++dt)
#pragma unroll
                for (int a4 = 0; a4 < 4; ++a4) {
                    LAS u32x2* p = (LAS u32x2*)(orow + (((dt * 8 + a4 * 2 + h) ^ fsw) << 3));
                    f32x4 v;
#pragma unroll
                    for (int j = 0; j < 4; ++j) v[j] = (dt ? O1[4 * a4 + j] : O0[4 * a4 + j]) * wn;
                    if (g > 0) { const u32x2 ow = *p; v[0] += wo * bflo(ow.x); v[1] += wo * bfhi(ow.x); v[2] += wo * bflo(ow.y); v[3] += wo * bfhi(ow.y); }
                    u32x2 nw; nw.x = pk2(v[0], v[1]); nw.y = pk2(v[2], v[3]); *p = nw;
                }
            if (h == 0) LSE[tokidx] = lnew;
        }
        __syncthreads();
    }
    bf16* mo = MERGED + ((size_t)b * SEQ + chunk * 512) * PMW + 512 + hq * 64;
#pragma unroll
    for (int it = 0; it < 8; ++it) { const int idx = tid + 512 * it, tok = idx >> 3, pc = idx & 7;
        const int fsw = (tok ^ (tok >> 4)) & 15;
        u32x4 w = *(const LAS u32x4*)(lds + tok * AT_OPITCH + ((pc ^ (fsw >> 1)) << 4));
        if (fsw & 1) w = (u32x4){w.z, w.w, w.x, w.y};
        *(u32x4*)(mo + (size_t)tok * PMW + pc * 8) = w; }
    __syncthreads();
}

__device__ __forceinline__ void pool_unit(LAS unsigned char* lds, const bf16* Z, bf16* POOLED, int b, int t0, int wid, int lane, int tid) {
    const bf16* zb = Z + (size_t)b * SEQ * 512;
    { u32x4 rv[10];
#pragma unroll
      for (int k = 0; k < 10; ++k) { int t = t0 - 8 + wid + 8 * k; t = t < 0 ? 0 : (t >= SEQ ? SEQ - 1 : t); rv[k] = *(const u32x4*)(zb + (size_t)t * 512 + lane * 8); }
#pragma unroll
      for (int k = 0; k < 10; ++k) *(LAS u32x4*)(lds + (wid + 8 * k) * 1024 + lane * 16) = rv[k]; }
    __syncthreads();
#pragma unroll 1
    for (int k = 0; k < 8; ++k) { const int gi = (wid + k) & 3, slot = wid * 2 + (k >> 2), tl = slot * 4 + (lane >> 4), cu = gi * 16 + (lane & 15), t = t0 + tl, hw = 1 << gi;
        const int lo = (t - hw) < 0 ? 0 : (t - hw), hi = (t + hw) > SEQ ? SEQ : (t + hw);
        f32x4 s0 = (f32x4){0.f, 0.f, 0.f, 0.f}, s1 = s0;
        for (int j = lo; j < hi; ++j) { const u32x4 w = *(const LAS u32x4*)(lds + (j - t0 + 8) * 1024 + cu * 16); f32x4 a0, a1; ep::unpack8(w, a0, a1); s0 += a0; s1 += a1; }
        const float ic = 1.0f / (float)(hi - lo);
        const u32x4 w = *(const LAS u32x4*)(lds + (tl + 8) * 1024 + cu * 16); f32x4 a0, a1; ep::unpack8(w, a0, a1);
        s0 = s0 * ic - a0; s1 = s1 * ic - a1;
        u32x4 o; o.x = pk2(s0[0], s0[1]); o.y = pk2(s0[2], s0[3]); o.z = pk2(s1[0], s1[1]); o.w = pk2(s1[2], s1[3]);
        *(u32x4*)(POOLED + ((size_t)b * SEQ + t) * PMW + cu * 8) = o; }
    __syncthreads();
}

#define XB_TMO      128
#define XB_XCNT(j)  (256  + 64 * (j))
#define XB_XSUB(j)  (1280 + 64 * (j))
#define XB_XGEN(j)  (2304 + 64 * (j))
#define XB_TOP      3328
#define XB_TOPGEN   3392
#define XCD_BAR_WORDS 3456
#define XB_SPIN_CAP (1u << 18)

__device__ __forceinline__ unsigned xb_ld(unsigned* p)              { return __hip_atomic_load(p, __ATOMIC_RELAXED, __HIP_MEMORY_SCOPE_AGENT); }
__device__ __forceinline__ unsigned xb_add(unsigned* p, unsigned v) { return __hip_atomic_fetch_add(p, v, __ATOMIC_RELAXED, __HIP_MEMORY_SCOPE_AGENT); }
__device__ __forceinline__ unsigned xb_xcc_id() { return (unsigned)__builtin_amdgcn_s_getreg((3 << 11) | 20) & 0xFu; }
#define XB_SPIN(cond, bar) do { unsigned _sp = 0; while (cond) { __builtin_amdgcn_s_sleep(1); \
    if ((++_sp & 255u) == 0u) { if (xb_ld(&(bar)[XB_TMO])) break; if (_sp > XB_SPIN_CAP) { atomicAdd(&(bar)[XB_TMO], 1u); break; } } } } while (0)

struct XcdBarrier {
    unsigned* bar; unsigned x;
    volatile LAS unsigned* st;
};

__device__ __forceinline__ XcdBarrier xcd_barrier_post(unsigned* bar, volatile LAS unsigned* st) {
    XcdBarrier b; b.bar = bar; b.x = xb_xcc_id(); b.st = st;
    if (threadIdx.x == 0) (void)xb_add(&bar[XB_XCNT(b.x)], 1u);
    return b;
}
__device__ __forceinline__ void xcd_barrier_complete(unsigned* bar, unsigned x, unsigned& nloc, unsigned& nx) {
    const unsigned G = gridDim.x * gridDim.y * gridDim.z;
    unsigned sum, cnt, mine, sp = 0u;
    for (;;) {
        sum = 0u; cnt = 0u; mine = 0u;
#pragma unroll
        for (unsigned j = 0; j < 16; ++j) { const unsigned c = xb_ld(&bar[XB_XCNT(j)]); sum += c; cnt += (c > 0u) ? 1u : 0u; mine = (j == x) ? c : mine; }
        if (sum == G) break;
        __builtin_amdgcn_s_sleep(1);
        if ((++sp & 255u) == 0u) { if (xb_ld(&bar[XB_TMO])) break; if (sp > XB_SPIN_CAP) { atomicAdd(&bar[XB_TMO], 1u); break; } }
    }
    nloc = mine > 0u ? mine : 1u; nx = cnt > 0u ? cnt : 1u;
}

__device__ __forceinline__ void xcd_barrier(const XcdBarrier& b) {
    asm volatile("s_waitcnt vmcnt(0)" ::: "memory");
    __syncthreads();
    if (threadIdx.x == 0) {
        unsigned* bar = b.bar;
        __builtin_amdgcn_s_waitcnt(0);
        unsigned nloc = b.st[0], nx = b.st[1];
        if (nloc == 0u) { xcd_barrier_complete(bar, b.x, nloc, nx); b.st[0] = nloc; b.st[1] = nx; }
        const unsigned old = xb_add(&bar[XB_XSUB(b.x)], 1u);
        const unsigned gen = old / nloc;
        if (old + 1u == (gen + 1u) * nloc) {
            __builtin_amdgcn_fence(__ATOMIC_RELEASE, "agent");
            asm volatile("s_waitcnt vmcnt(0)" ::: "memory");
            const unsigned og = xb_add(&bar[XB_TOP], 1u);
            const unsigned tg = og / nx;
            if (og + 1u == (tg + 1u) * nx) xb_add(&bar[XB_TOPGEN], 1u);
            else XB_SPIN(xb_ld(&bar[XB_TOPGEN]) == tg, bar);
            __builtin_amdgcn_fence(__ATOMIC_ACQUIRE, "agent");
            xb_add(&bar[XB_XGEN(b.x)], 1u);
            asm volatile("s_waitcnt vmcnt(0)" ::: "memory");
        } else {
            XB_SPIN(xb_ld(&bar[XB_XGEN(b.x)]) == gen, bar);
            __builtin_amdgcn_fence(__ATOMIC_ACQUIRE, "agent");
            asm volatile("s_waitcnt vmcnt(0)" ::: "memory");
        }
    }
    __syncthreads();
}

struct Args { const float* in[16]; float* out; unsigned char* ws; int ph_lo, ph_hi; };

__global__ void __launch_bounds__(NWAVES * 64, 2) mk_fwd(Args args) {
    extern __shared__ __attribute__((aligned(16))) unsigned char lds_raw[];
    LAS unsigned char* lds = (LAS unsigned char*)lds_raw;
    cg::grid_group grid = cg::this_grid();
    const int tid = threadIdx.x, lane = tid & 63, wid = __builtin_amdgcn_readfirstlane(tid >> 6);
    const int G = gridDim.x, bx = blockIdx.x;
    const int vcu = (G % 8 == 0) ? (bx % 8) * (G / 8) + bx / 8 : bx;
    const __attribute__((address_space(4))) unsigned char* ka = (const __attribute__((address_space(4))) unsigned char*)__builtin_amdgcn_kernarg_segment_ptr();
    typedef const float* cfp_t; typedef unsigned char* ucp_t;
#define ARG_IN(i) (*(volatile cfp_t __attribute__((address_space(4)))*)(ka + 8 * (i)))
#define ARG_OUT() ((float*)*(volatile cfp_t __attribute__((address_space(4)))*)(ka + 128))
#define ARG_WS() (*(volatile ucp_t __attribute__((address_space(4)))*)(ka + 136))
#define WSP(off) ((bf16*)(ws + (off)))
    const int lo = args.ph_lo, hi = args.ph_hi;
    volatile LAS unsigned* xb_st = (volatile LAS unsigned*)(lds + RING_BYTES + 8192);
    if (tid < 2) xb_st[tid] = 0u;
    __syncthreads();
    const unsigned sk8 = (unsigned)((bx >> 3) & 7);
#ifndef PH_MASK
#define PH_MASK 255
#endif
#define IN(k) (((PH_MASK >> (k)) & 1) && lo <= (k) && (k) < hi)
#define SEAM(k) do { if (IN(k) && IN((k) + 1)) { if ((k) == 0) grid.sync(); else { XcdBarrier xb_; xb_.bar = (unsigned*)ARG_WS(); xb_.x = xb_xcc_id(); xb_.st = xb_st; xcd_barrier(xb_); } } } while (0)
#ifndef PROBE_DUP
#define PROBE_DUP -1
#endif
#define REPS(k) for (int rep_ = 0; rep_ < ((PROBE_DUP == (k)) ? 2 : 1); ++rep_)

    REPS(0) if (IN(0)) { if (rep_) grid.sync();
        unsigned char* ws = ARG_WS();
        bf16* W1T = WSP(WS_W1T); bf16* WPT = WSP(WS_WPT); bf16* WOT = WSP(WS_WOT); bf16* WGUT = WSP(WS_WGUT); bf16* WDT = WSP(WS_WDT);
        float* ROPE = (float*)(ws + WS_ROPE); bf16* XB = WSP(WS_XB);
        LAS float* scr = (LAS float*)(lds + wid * 16384);
        const int gw = vcu * NWAVES + wid, NGW = G * NWAVES;
        constexpr int I_IN = (DM / 64) * (ZW / 32), I_G = (DM / 64) * (GW / 32), I_UA = (256 / 64) * (DM / 32), I_O = (DM / 64) * (DM / 32), I_F = (DM / 64) * (FF / 32), I_D = (FF / 64) * (DM / 32);
        constexpr int NITEMS = I_IN + I_G + I_UA + I_O + 2 * I_F + I_D;
        for (int it = gw; it < NITEMS; it += NGW) {
            int r = it;
            if (r < I_IN) { p0_transpose_item(ARG_IN(3), DM, ZW, W1T, 2, 0, ARG_IN(2), scr, r, lane); continue; } r -= I_IN;
            if (r < I_G) { p0_transpose_item(ARG_IN(8), DM, GW, W1T, 3, ZW, ARG_IN(2), scr, r, lane); continue; } r -= I_G;
            if (r < I_UA) { p0_transpose_item(ARG_IN(7), 256, DM, WPT, 3, 0, nullptr, scr, r, lane, PMW, 512); continue; } r -= I_UA;
            if (r < I_O) { p0_transpose_item(ARG_IN(10), DM, DM, WOT, 3, 0, nullptr, scr, r, lane); continue; } r -= I_O;
            if (r < I_F) { p0_transpose_item(ARG_IN(12), DM, FF, WGUT, 1, 0, ARG_IN(11), scr, r, lane); continue; } r -= I_F;
            if (r < I_F) { p0_transpose_item(ARG_IN(13), DM, FF, WGUT, 1, 128, ARG_IN(11), scr, r, lane); continue; } r -= I_F;
            p0_transpose_item(ARG_IN(14), FF, DM, WDT, 3, 0, nullptr, scr, r, lane);
        }
        for (int it = vcu; it < 128; it += G) { const int g = it >> 5, cb = (it >> 1) & 15, n = (it & 1) * 512 + tid;
            const float* maps = ARG_IN(4) + (size_t)(g * 128 + cb * 8) * 128; const float* sc = ARG_IN(5) + g * 128; const float* wu = ARG_IN(6) + (size_t)g * 128 * DM + n;
            float a[8];
#pragma unroll
            for (int ci = 0; ci < 8; ++ci) a[ci] = 0.f;
#pragma unroll 16
            for (int dd = 0; dd < 128; ++dd) { const float w = wu[(size_t)dd * DM] * sc[dd];
#pragma unroll
                for (int ci = 0; ci < 8; ++ci) a[ci] += maps[ci * 128 + dd] * w; }
            u32x4 o; o.x = pk2(a[0], a[1]); o.y = pk2(a[2], a[3]); o.z = pk2(a[4], a[5]); o.w = pk2(a[6], a[7]);
            { const int a_ = n & 255, np = (n & ~255) + 128 * ((a_ >> 5) & 1) + 32 * (a_ >> 6) + (a_ & 31);
              *(u32x4*)(WPT + (size_t)np * PMW + g * 128 + cb * 8) = o; } }
        for (int i = vcu * 512 + tid; i < 384 * 64; i += G * 512) ((unsigned*)(ws + WS_CNT))[i] = 0u;
        for (int i = vcu * 512 + tid; i < 4096; i += G * 512) ((unsigned*)ws)[i] = 0u;
        for (int i = vcu * 512 + tid; i < SEQ * 8; i += G * 512) { const int pos = i >> 3, f = i & 7;
            const float invf = exp2f(-(float)f * (18.931568569324174f / 8.0f));
            const double rev = (double)pos * (double)invf * 0.15915494309189535; const float fr_ = (float)(rev - __builtin_rint(rev));
            const float sn = __builtin_amdgcn_sinf(fr_), cs = __builtin_amdgcn_cosf(fr_);
            ROPE[pos * 16 + f] = cs; ROPE[pos * 16 + 8 + f] = sn; }
        for (int m0 = gw * 4; m0 < T; m0 += NGW * 4) {
            f32x4 v[4][4];
#pragma unroll
            for (int rr = 0; rr < 4; ++rr) { const int m = m0 + rr;
                const float* xrow = (m < 32 * SEQ) ? ARG_IN(0) + (size_t)m * DM : ARG_IN(1) + (size_t)(m - 32 * SEQ) * DM;
                const f32x4* xr = (const f32x4*)xrow + lane;
#pragma unroll
                for (int j = 0; j < 4; ++j) v[rr][j] = xr[64 * j]; }
#pragma unroll
            for (int rr = 0; rr < 4; ++rr) { float s = 0.f;
#pragma unroll
                for (int j = 0; j < 4; ++j) s += (v[rr][j].x * v[rr][j].x + v[rr][j].y * v[rr][j].y) + (v[rr][j].z * v[rr][j].z + v[rr][j].w * v[rr][j].w);
                const float rstd = 1.0f / sqrtf(wave_sum(s) * (1.0f / DM) + EPS);
                u32x2* o8 = (u32x2*)(XB + (size_t)(m0 + rr) * DM) + lane;
#pragma unroll
                for (int j = 0; j < 4; ++j) { u32x2 w; w.x = pk2(v[rr][j].x * rstd, v[rr][j].y * rstd); w.y = pk2(v[rr][j].z * rstd, v[rr][j].w * rstd); o8[64 * j] = w; } }
        }
        __syncthreads();
    }
    SEAM(0);
    if (IN(0) && IN(1)) (void)xcd_barrier_post((unsigned*)ARG_WS(), xb_st);
    REPS(1) if (IN(1)) { if (rep_) grid.sync();
        unsigned char* ws = ARG_WS();
        pg8::Gemm g{WSP(WS_XB), WSP(WS_W1T), T, N1, DM}; pg8::StaticOrder S; S.init(T, N1, G, bx);
        { LAS float* bl = (LAS float*)(lds + RING_BYTES); const float* bg = ARG_IN(9);
          for (int i = tid; i < GW; i += NWAVES * 64) bl[i] = bg[i] * -1.4426950408889634f;
          __syncthreads(); }
        ep::EpiZG E{WSP(WS_Z), (bf16*)ARG_OUT(), (const LAS float*)(lds + RING_BYTES), (const float*)(ws + WS_ROPE)};
        skew_wait((unsigned)SKEW1 * (unsigned)((bx < 128 ? 0 : 4) + ((bx >> 3) & 3)));
        pg8::gemm_phase<ep::EpiZG, pg8::StaticOrder, true, true>(lds, g, S, E);
    }
    SEAM(1);
    REPS(2) if (IN(2)) { if (rep_) grid.sync();
        unsigned char* ws = ARG_WS(); const bf16* Z = WSP(WS_Z); bf16* MERGED = WSP(WS_PM); bf16* POOLED = WSP(WS_PM);
        for (int u = vcu; u < NB * 16; u += G) attn_unit(lds, Z, MERGED, u >> 4, (u >> 2) & 3, u & 3, wid, lane, tid);
        for (int u = vcu; u < NB * 32; u += G) pool_unit(lds, Z, POOLED, u >> 5, (u & 31) * 64, wid, lane, tid);
#if PROBE_DUP == 22
        for (int u = vcu; u < NB * 32; u += G) pool_unit(lds, Z, POOLED, u >> 5, (u & 31) * 64, wid, lane, tid);
#endif
    }
    SEAM(2);
    REPS(3) if (IN(3)) { if (rep_) grid.sync();
        unsigned char* ws = ARG_WS();
        pg8::Gemm g{WSP(WS_PM), WSP(WS_WPT), T, DM, PMW}; pg8::StaticOrder S; S.init(T, DM, G, bx); ep::EpiGateCat E{WSP(WS_Z), (const bf16*)ARG_OUT()};
        pg8::gemm_phase<ep::EpiGateCat, pg8::StaticOrder, true, true>(lds, g, S, E);
    }
    SEAM(3);
    REPS(4) if (IN(4)) { if (rep_) grid.sync();
        unsigned char* ws = ARG_WS();
        pg8::Gemm g{WSP(WS_Z), WSP(WS_WOT), T, DM, DM}; pg8::StaticOrder S; S.init(T, DM, G, bx);
        skew_wait((unsigned)SKEW4 * sk8);
        ep::EpiRes E{ARG_IN(0), ARG_IN(1) - (size_t)32 * SEQ * DM, WSP(WS_XB), (float*)(ws + WS_SSQ2), (LAS float*)(lds + RING_BYTES)};
        pg8::gemm_phase<ep::EpiRes, pg8::StaticOrder, true, true>(lds, g, S, E);
    }
    SEAM(4);
    REPS(5) if (IN(5)) { if (rep_) grid.sync();
        unsigned char* ws = ARG_WS();
        pg8::Gemm g{WSP(WS_XB), WSP(WS_WGUT), T, 2 * FF, DM}; pg8::StaticOrder S; S.init(T, 2 * FF, G, bx);
        skew_wait((unsigned)SKEW5 * sk8);
#if PROBE_DUP == 5
        if (rep_ == 0) { ep::EpiDry E{(float*)(ws + WS_SLOTS)}; pg8::gemm_phase<ep::EpiDry, pg8::StaticOrder, true, true>(lds, g, S, E); } else
#endif
        { ep::EpiSwiGLU E{WSP(WS_Z), (const float*)(ws + WS_SSQ2), (LAS float*)(lds + RING_BYTES)};
        pg8::gemm_phase<ep::EpiSwiGLU, pg8::StaticOrder, true, true>(lds, g, S, E); }
    }
    SEAM(5);
    if (IN(6)) {
        unsigned char* ws = ARG_WS();
        pg8::Gemm g{WSP(WS_Z), WSP(WS_WDT), T, DM, FF}; pg8::StaticOrder S; S.init(T, DM, G, bx);
        skew_wait((unsigned)SKEW6 * sk8);
        ep::EpiFinal E{ARG_OUT(), WSP(WS_XB), ARG_IN(15), (unsigned*)(ws + WS_SLOTS), (unsigned*)(ws + WS_CNT), (LAS float*)(lds + RING_BYTES)};
        pg8::gemm_phase<ep::EpiFinal, pg8::StaticOrder, true, true>(lds, g, S, E);
    }
#undef IN
#undef SEAM
}

extern "C" void kernel_launch(void* const* d_in, const int* in_sizes, int n_in, void* d_out, int out_size, void* d_ws, size_t ws_size, hipStream_t stream) {
    static int grid = 0;
    if (grid == 0) {
        if (n_in != 16 || in_sizes[0] != 32 * SEQ * DM || in_sizes[1] != 16 * SEQ * DM || out_size != T * DM || ws_size < WS_END) {
            fprintf(stderr, "kernel_launch: unexpected shapes (n_in %d out %d ws %zu)\n", n_in, out_size, ws_size); grid = -1; return; }
        int dev = 0, cus = 0, per_cu = 0;
        hipGetDevice(&dev); hipDeviceGetAttribute(&cus, hipDeviceAttributeMultiprocessorCount, dev);
        hipFuncSetAttribute((const void*)mk_fwd, hipFuncAttributeMaxDynamicSharedMemorySize, LDS_BYTES);
        hipOccupancyMaxActiveBlocksPerMultiprocessor(&per_cu, (const void*)mk_fwd, NWAVES * 64, LDS_BYTES);
        (void)hipGetLastError();
        if (per_cu < 1) per_cu = 1;
        grid = cus * 1;
    }
    if (grid < 0) return;
    Args a{};
    for (int i = 0; i < 16; ++i) a.in[i] = (const float*)d_in[i];
    a.out = (float*)d_out; a.ws = (unsigned char*)d_ws;
#if MK_ONE_LAUNCH
    a.ph_lo = 0; a.ph_hi = 7;
    void* kargs[] = {&a};
    hipError_t e = hipLaunchCooperativeKernel((const void*)mk_fwd, dim3(grid), dim3(NWAVES * 64), kargs, LDS_BYTES, stream);
    if (e != hipSuccess) fprintf(stderr, "cooperative launch failed: %s (grid %d)\n", hipGetErrorString(e), grid);
#else
    for (int p = 0; p < 7; ++p) { a.ph_lo = p; a.ph_hi = p + 1; hipLaunchKernelGGL(mk_fwd, dim3(grid), dim3(NWAVES * 64), LDS_BYTES, stream, a); }
#endif
}
```
